# Optimizing an MI355X kernel written in HIP

```python
import math
import jax, jax.numpy as jnp
from jax import lax
import numpy as np

D_MODEL = 2048
BATCH = 2
SEQ = 16384
DEPTH = 2

N_BRANCH = 4
BRANCH_W = D_MODEL // N_BRANCH
A_HEAD_DIM = 64
A_HEADS = BRANCH_W // A_HEAD_DIM
DILATED_PATTERNS = ((128, 1), (512, 4), (2048, 16))
BAND = 128
DIFF_QK_DIM = 64
DIFF_V_DIM = 2 * DIFF_QK_DIM
B_HEADS = BRANCH_W // DIFF_V_DIM
Q_BLOCK = 128
DN_HEAD_K = 128
DN_HEAD_V = 128
C_HEADS = BRANCH_W // DN_HEAD_V
CONV_K = 4
CHUNK = 64
HG_EXPAND = 128
HG_HEAD_V = 128
D_HEADS = BRANCH_W // HG_HEAD_V
NUM_BUCKETS = 32
MAX_DISTANCE = 2048
RMS_EPS = 1e-6

IN_SPLITS = (
    A_HEADS * A_HEAD_DIM, A_HEADS * A_HEAD_DIM, A_HEADS * A_HEAD_DIM, BRANCH_W,
    B_HEADS * 2 * DIFF_QK_DIM, B_HEADS * 2 * DIFF_QK_DIM, B_HEADS * DIFF_V_DIM, BRANCH_W,
    C_HEADS * (2 * DN_HEAD_K + DN_HEAD_V), BRANCH_W, C_HEADS, C_HEADS,
    D_HEADS * HG_EXPAND, D_HEADS * HG_EXPAND, D_HEADS * HG_HEAD_V, BRANCH_W,
    N_BRANCH * D_MODEL,
)
N_IN_COLS = sum(IN_SPLITS)

kernel_name = "hybrid_gated_four_mixer_block"


def rms_norm(x, gain):
    x32 = x.astype(jnp.float32)
    y = x32 * lax.rsqrt(jnp.mean(x32 * x32, axis=-1, keepdims=True) + RMS_EPS)
    return y * gain.astype(jnp.float32)


def l2norm(x):
    return x * lax.rsqrt(jnp.sum(x * x, axis=-1, keepdims=True) + 1e-6)


def t5_bucket(dist):
    n = jnp.maximum(dist, 0)
    max_exact = NUM_BUCKETS // 2
    nf = jnp.maximum(n, max_exact).astype(jnp.float32)
    large = max_exact + (jnp.log(nf / max_exact) / math.log(MAX_DISTANCE / max_exact)
                         * (NUM_BUCKETS - max_exact)).astype(jnp.int32)
    large = jnp.minimum(large, NUM_BUCKETS - 1)
    return jnp.where(n < max_exact, n, large)


def dilated_window_attention(q, k, v, bias_table):
    Bsz, T, H, dh = q.shape
    scale = dh ** -0.5
    qi = jnp.arange(BAND)[:, None]
    kj = jnp.arange(2 * BAND)[None, :]
    rel = qi + BAND - kj
    outs, lses = [], []
    for window, dil in DILATED_PATTERNS:
        n = T // dil
        nb = -(-n // BAND)
        n_pad = nb * BAND

        def to_blocks(t):
            t = t.reshape(Bsz, n, dil, H, dh).transpose(0, 2, 1, 3, 4)
            t = jnp.pad(t, ((0, 0), (0, 0), (0, n_pad - n), (0, 0), (0, 0)))
            return t.reshape(Bsz, dil, nb, BAND, H, dh)

        def with_prev(t):
            prev = jnp.pad(t[:, :, :-1], ((0, 0), (0, 0), (1, 0), (0, 0), (0, 0), (0, 0)))
            return jnp.concatenate([prev, t], axis=3)

        qb = to_blocks(q)
        kb = with_prev(to_blocks(k))
        vb = with_prev(to_blocks(v))
        bias = bias_table[t5_bucket(rel * dil)].transpose(2, 0, 1)
        key_idx = jnp.arange(nb)[:, None, None] * BAND + kj[None] - BAND
        valid = ((rel >= 0) & (rel <= window // dil))[None] & (key_idx >= 0)
        logits = jnp.einsum('bcnqhd,bcnkhd->bcnhqk', qb, kb) * scale + bias
        logits = jnp.where(valid[:, None], logits, -jnp.inf)
        m = jnp.max(logits, axis=-1, keepdims=True)
        p = jnp.exp(logits - m)
        l = jnp.sum(p, axis=-1, keepdims=True)
        o = jnp.einsum('bcnhqk,bcnkhd->bcnhqd', p, vb) / l
        lse = (m + jnp.log(l))[..., 0]
        o = o.transpose(0, 1, 2, 4, 3, 5).reshape(Bsz, dil, n_pad, H, dh)[:, :, :n]
        lse = lse.transpose(0, 1, 2, 4, 3).reshape(Bsz, dil, n_pad, H)[:, :, :n]
        outs.append(o.transpose(0, 2, 1, 3, 4).reshape(Bsz, T, H, dh))
        lses.append(lse.transpose(0, 2, 1, 3).reshape(Bsz, T, H))
    w = jax.nn.softmax(jnp.stack(lses), axis=0)
    return jnp.einsum('pbth,pbthd->bthd', w, jnp.stack(outs))


def diff_attention(q, k, v, bias_table, lam):
    Bsz, T, H, _, dqk = q.shape
    scale = dqk ** -0.5
    nb = T // Q_BLOCK
    qb = q.reshape(Bsz, nb, Q_BLOCK, H, 2, dqk).transpose(1, 0, 2, 3, 4, 5)
    kpos = jnp.arange(T)

    def block(args):
        qblk, bi = args
        qpos = bi * Q_BLOCK + jnp.arange(Q_BLOCK)
        rel = qpos[:, None] - kpos[None, :]
        bias = bias_table[t5_bucket(rel)].transpose(2, 0, 1)
        logits = jnp.einsum('bqhmd,bkhmd->bhmqk', qblk, k) * scale + bias[:, None]
        logits = jnp.where(rel >= 0, logits, -jnp.inf)
        p = jax.nn.softmax(logits, axis=-1)
        attn = p[:, :, 0] - lam * p[:, :, 1]
        return jnp.einsum('bhqk,bkhd->bqhd', attn, v)

    o = lax.map(block, (qb, jnp.arange(nb)))
    return o.transpose(1, 0, 2, 3, 4).reshape(Bsz, T, H, -1)


def to_chunks(t):
    Bsz, T, H = t.shape[:3]
    t = t.reshape(Bsz, T // CHUNK, CHUNK, H, *t.shape[3:])
    return jnp.moveaxis(t, (1, 3), (0, 2))


def from_chunks(o):
    o = jnp.moveaxis(o, (0, 2), (1, 3))
    Bsz, nc, C, H, d = o.shape
    return o.reshape(Bsz, nc * C, H, d)


def short_conv(x, w):
    K, C = w.shape
    return lax.conv_general_dilated(x, w[:, None, :], window_strides=(1,), padding=[(K - 1, 0)],
                                    dimension_numbers=('NWC', 'WIO', 'NWC'), feature_group_count=C)


def gated_delta_net(q, k, v, beta, g):
    Bsz, T, H, dk = q.shape
    dv = v.shape[-1]
    qc, kc, vc = to_chunks(q), to_chunks(k), to_chunks(v)
    bc, gc = to_chunks(beta), to_chunks(g)
    G = jnp.cumsum(gc, axis=-1)
    tri = jnp.tril(jnp.ones((CHUNK, CHUNK), bool))
    strict = jnp.tril(jnp.ones((CHUNK, CHUNK), bool), -1)
    gamma = jnp.exp(jnp.where(tri, G[..., :, None] - G[..., None, :], -jnp.inf))
    kk = jnp.einsum('nbhid,nbhjd->nbhij', kc, kc)
    M = jnp.where(strict, bc[..., :, None] * kk * gamma, 0.0)
    eye = jnp.eye(CHUNK, dtype=M.dtype)
    rhs = jnp.concatenate([vc * bc[..., None], kc * (bc * jnp.exp(G))[..., None]], axis=-1)
    sol = lax.linalg.triangular_solve(M + eye, rhs, left_side=True, lower=True, unit_diagonal=True)
    U, W = sol[..., :dv], sol[..., dv:]
    Aqk = jnp.einsum('nbhid,nbhjd->nbhij', qc, kc) * gamma
    q_dec = qc * jnp.exp(G)[..., None]
    k_dec = kc * jnp.exp(G[..., -1:] - G)[..., None]
    g_last = jnp.exp(G[..., -1])

    def step(S, inp):
        u, w, a, qd, kd, gl = inp
        v_new = u - jnp.einsum('bhcd,bhde->bhce', w, S)
        o = jnp.einsum('bhcd,bhde->bhce', qd, S) + jnp.einsum('bhij,bhje->bhie', a, v_new)
        S = gl[..., None, None] * S + jnp.einsum('bhcd,bhce->bhde', kd, v_new)
        return S, o

    S0 = jnp.zeros((Bsz, H, dk, dv), jnp.float32)
    _, o = lax.scan(step, S0, (U, W, Aqk, q_dec, k_dec, g_last))
    return from_chunks(o)


def hgrn2(q, k, logf, v):
    Bsz, T, H, dk = q.shape
    dv = v.shape[-1]
    tri = jnp.tril(jnp.ones((CHUNK, CHUNK), bool))

    def step(S, inp):
        qc, kc, gc, vc = inp
        Bc = jnp.cumsum(gc, axis=2)
        o_inter = jnp.einsum('bhcd,bhde->bhce', qc * jnp.exp(Bc), S)
        diff = Bc[:, :, :, None, :] - Bc[:, :, None, :, :]
        dec = jnp.exp(jnp.where(tri[:, :, None], diff, -jnp.inf))
        A = jnp.einsum('bhid,bhjd,bhijd->bhij', qc, kc, dec)
        o = o_inter + jnp.einsum('bhij,bhje->bhie', A, vc)
        bl = Bc[:, :, -1]
        S = jnp.exp(bl)[..., None] * S + jnp.einsum('bhcd,bhce->bhde', kc * jnp.exp(bl[:, :, None] - Bc), vc)
        return S, o

    S0 = jnp.zeros((Bsz, H, dk, dv), jnp.float32)
    _, o = lax.scan(step, S0, (to_chunks(q), to_chunks(k), to_chunks(logf), to_chunks(v)))
    return from_chunks(o)


def setup_inputs(seed: int = 0) -> dict:
    key = jax.random.key(seed)
    ks = jax.random.split(key, 16)
    f32 = jnp.float32
    nrm = lambda k, s: jax.random.normal(k, s, f32)
    x = nrm(ks[0], (BATCH, SEQ, D_MODEL))
    norm_gain = 1.0 + 0.02 * nrm(ks[1], (DEPTH, D_MODEL))
    w_in = nrm(ks[2], (DEPTH, D_MODEL, N_IN_COLS)) * D_MODEL ** -0.5
    rel_bias = 0.1 * nrm(ks[3], (NUM_BUCKETS, A_HEADS + B_HEADS))
    diff_lambda = 0.1 * nrm(ks[4], (DEPTH, 4, DIFF_QK_DIM))
    diff_subln_gain = 1.0 + 0.02 * nrm(ks[5], (DEPTH, DIFF_V_DIM))
    dn_conv = nrm(ks[6], (DEPTH, CONV_K, C_HEADS * (2 * DN_HEAD_K + DN_HEAD_V))) * CONV_K ** -0.5
    dn_a_log = jnp.log(jax.random.uniform(ks[7], (DEPTH, C_HEADS), f32, 1.0, 16.0))
    dt = jnp.exp(jax.random.uniform(ks[8], (DEPTH, C_HEADS), f32, math.log(1e-3), math.log(1e-1)))
    dn_dt_bias = dt + jnp.log(-jnp.expm1(-dt))
    dn_norm_gain = 1.0 + 0.02 * nrm(ks[9], (DEPTH, DN_HEAD_V))
    hg_lb_logits = 0.5 * nrm(ks[10], (DEPTH, D_HEADS * HG_EXPAND))
    hg_norm_gain = 1.0 + 0.02 * nrm(ks[11], (DEPTH, HG_HEAD_V))
    w_branch = nrm(ks[12], (DEPTH, N_BRANCH, BRANCH_W, D_MODEL)) * BRANCH_W ** -0.5
    w_out = nrm(ks[13], (DEPTH, D_MODEL, D_MODEL)) * D_MODEL ** -0.5
    final_gain = 1.0 + 0.02 * nrm(ks[14], (D_MODEL,))
    return {"x": x, "norm_gain": norm_gain, "w_in": w_in, "rel_bias": rel_bias,
            "diff_lambda": diff_lambda, "diff_subln_gain": diff_subln_gain, "dn_conv": dn_conv,
            "dn_a_log": dn_a_log, "dn_dt_bias": dn_dt_bias, "dn_norm_gain": dn_norm_gain,
            "hg_lb_logits": hg_lb_logits, "hg_norm_gain": hg_norm_gain, "w_branch": w_branch,
            "w_out": w_out, "final_gain": final_gain}


def reference(x, norm_gain, w_in, rel_bias, diff_lambda, diff_subln_gain, dn_conv, dn_a_log,
              dn_dt_bias, dn_norm_gain, hg_lb_logits, hg_norm_gain, w_branch, w_out, final_gain):
    f32 = jnp.float32
    Bsz, T, _ = x.shape
    silu = jax.nn.silu
    heads = lambda t, n: t.reshape(Bsz, T, n, -1)
    lb_p = jax.nn.softmax(hg_lb_logits.astype(f32), axis=0)
    hg_lb = jnp.clip(jnp.cumsum(lb_p, axis=0) - lb_p[0], 0.0, 1.0)
    bias_a = rel_bias[:, :A_HEADS].astype(f32)
    bias_b = rel_bias[:, A_HEADS:].astype(f32)
    split_at = [int(s) for s in np.cumsum(IN_SPLITS)[:-1]]
    for layer in range(DEPTH):
        h = rms_norm(x, norm_gain[layer])
        (a_q, a_k, a_v, a_gate, b_q, b_k, b_v, b_gate, c_qkv, c_z, c_beta, c_a,
         d_q, d_f, d_i, d_gate, merge) = jnp.split(h @ w_in[layer].astype(f32), split_at, axis=-1)

        o_a = dilated_window_attention(heads(a_q, A_HEADS), heads(a_k, A_HEADS), heads(a_v, A_HEADS), bias_a)
        y_a = o_a.reshape(Bsz, T, -1) * silu(a_gate)

        lam_init = 0.8 - 0.6 * math.exp(-0.3 * layer)
        lq1, lk1, lq2, lk2 = diff_lambda[layer].astype(f32)
        lam = jnp.exp(jnp.sum(lq1 * lk1)) - jnp.exp(jnp.sum(lq2 * lk2)) + lam_init
        o_b = diff_attention(b_q.reshape(Bsz, T, B_HEADS, 2, DIFF_QK_DIM),
                             b_k.reshape(Bsz, T, B_HEADS, 2, DIFF_QK_DIM),
                             heads(b_v, B_HEADS), bias_b, lam)
        o_b = rms_norm(o_b, diff_subln_gain[layer]) * (1.0 - lam_init)
        y_b = o_b.reshape(Bsz, T, -1) * silu(b_gate)

        c_qkv = silu(short_conv(c_qkv, dn_conv[layer].astype(f32)))
        c_q, c_k, c_v = jnp.split(c_qkv, [C_HEADS * DN_HEAD_K, 2 * C_HEADS * DN_HEAD_K], axis=-1)
        c_q = l2norm(heads(c_q, C_HEADS)) * DN_HEAD_K ** -0.5
        c_k = l2norm(heads(c_k, C_HEADS))
        beta = jax.nn.sigmoid(c_beta)
        g = -jnp.exp(dn_a_log[layer].astype(f32)) * jax.nn.softplus(c_a + dn_dt_bias[layer].astype(f32))
        o_c = gated_delta_net(c_q, c_k, heads(c_v, C_HEADS), beta, g)
        y_c = rms_norm(o_c, dn_norm_gain[layer]).reshape(Bsz, T, -1) * silu(c_z)

        lb = hg_lb[layer]
        logf = jnp.logaddexp(jnp.log(lb), jnp.log1p(-lb) + jax.nn.log_sigmoid(d_f))
        d_k = (1.0 - lb) * jax.nn.sigmoid(-d_f)
        o_d = hgrn2(heads(d_q, D_HEADS), heads(d_k, D_HEADS), heads(logf, D_HEADS), heads(d_i, D_HEADS))
        y_d = rms_norm(o_d, hg_norm_gain[layer]).reshape(Bsz, T, -1) * silu(d_gate)

        gates = jax.nn.sigmoid(merge.reshape(Bsz, T, N_BRANCH, D_MODEL))
        w_br = w_branch[layer].astype(f32)
        mixed = gates[:, :, 0] * (y_a @ w_br[0])
        mixed = mixed + gates[:, :, 1] * (y_b @ w_br[1])
        mixed = mixed + gates[:, :, 2] * (y_c @ w_br[2])
        mixed = mixed + gates[:, :, 3] * (y_d @ w_br[3])
        x = x + (mixed @ w_out[layer].astype(f32)).astype(x.dtype)
    return rms_norm(x, final_gain).astype(x.dtype)
```

```cpp
#include <hip/hip_runtime.h>
#include <hip/hip_cooperative_groups.h>
#include <cstdio>
#include <cmath>
namespace cg = cooperative_groups;

#define DI __device__ __forceinline__
typedef unsigned short u16;
using bf16x8 = __attribute__((ext_vector_type(8))) short;
using bf16x4 = __attribute__((ext_vector_type(4))) short;
using f32x4  = __attribute__((ext_vector_type(4))) float;

constexpr int D = 2048, NB = 2, T = 16384, NT = NB * T;
constexpr int NIN = 16392;
constexpr int NP1 = 8320;
constexpr int NW = NP1 + 8192;
constexpr int NTHREADS = 512;
constexpr int LDS_BYTES = 131072;
#define NEG_INF (-INFINITY)

constexpr size_t SZ_WT = (size_t)NW * 2048 * 2;
constexpr size_t SZ_WBR = (size_t)4 * 2048 * 512 * 2;
constexpr size_t SZ_WOUT = (size_t)2048 * 2048 * 2;
constexpr size_t SZ_XB = (size_t)NT * 2048 * 2;
constexpr size_t SZ_GRP = (size_t)NT * 512 * 2;
constexpr size_t SZ_CA = (size_t)2048 * 4096 * 2;
constexpr size_t SZ_DEC = (size_t)2048 * 128 * 4;
constexpr size_t OFF_WT = 0;
constexpr size_t OFF_WBR = OFF_WT + SZ_WT;
constexpr size_t OFF_WOUT = OFF_WBR + SZ_WBR;
constexpr size_t OFF_XB = OFF_WOUT + SZ_WOUT;
constexpr size_t OFF_RSTD = OFF_XB + SZ_XB;
constexpr size_t OFF_GRP = OFF_RSTD + (size_t)NT * 4;
constexpr size_t OFF_BD = OFF_GRP + 16 * SZ_GRP;
constexpr size_t OFF_CU = OFF_BD + (size_t)NT * 8 * 4;
constexpr size_t OFF_CW = OFF_CU + SZ_GRP;
constexpr size_t OFF_CQ = OFF_CW + SZ_GRP;
constexpr size_t OFF_CKD = OFF_CQ + SZ_GRP;
constexpr size_t OFF_CA = OFF_CKD + SZ_GRP;
constexpr size_t OFF_CDEC = OFF_CA + SZ_CA;
constexpr size_t OFF_DKD = OFF_CDEC + SZ_DEC;
constexpr size_t OFF_DA = OFF_DKD + SZ_GRP;
constexpr size_t OFF_DDEC = OFF_DA + SZ_CA;
constexpr size_t OFF_CNT = OFF_DDEC + SZ_DEC;
constexpr size_t OFF_END = OFF_CNT + 256;
constexpr size_t OFF_MIXED = OFF_CU;

struct Params {
  const float *x, *norm_gain, *w_in, *rel_bias, *diff_lambda, *diff_subln, *dn_conv, *dn_a_log,
      *dn_dt_bias, *dn_norm_gain, *hg_lb_logits, *hg_norm_gain, *w_branch, *w_out, *final_gain;
  float* out;
  char* ws;
};

DI float bf2f(u16 b) { return __uint_as_float(((unsigned)b) << 16); }
DI u16 f2bf(float x) {
  unsigned u = __float_as_uint(x);
  u += 0x7fffu + ((u >> 16) & 1u);
  return (u16)(u >> 16);
}
DI unsigned pack2(float a, float b) { return (unsigned)f2bf(a) | ((unsigned)f2bf(b) << 16); }
DI float wave_sum(float v) {
#pragma unroll
  for (int o = 32; o > 0; o >>= 1) v += __shfl_xor(v, o);
  return v;
}
DI float sigmoidf_(float x) { return 1.f / (1.f + __expf(-x)); }
DI float siluf_(float x) { return x / (1.f + __expf(-x)); }
DI f32x4 mfma16(bf16x8 a, bf16x8 b, f32x4 c) { return __builtin_amdgcn_mfma_f32_16x16x32_bf16(a, b, c, 0, 0, 0); }
DI bf16x8 ld8(const u16* p) { return *reinterpret_cast<const bf16x8*>(p); }
DI bf16x4 ld4(const u16* p) { return *reinterpret_cast<const bf16x4*>(p); }
DI f32x4 zero4() { f32x4 z = {0.f, 0.f, 0.f, 0.f}; return z; }

DI int opaque_tid() { int t = threadIdx.x; asm volatile("" : "+v"(t)); return t; }
__shared__ int s_item;

DI int next_item(int* cnt) {
  __syncthreads();
  if (threadIdx.x == 0) s_item = atomicAdd(cnt, 1);
  __syncthreads();
  return s_item;
}

template <int WM, int WN>
DI void gemm_tile(const u16* __restrict__ A, int lda, const u16* __restrict__ Bt, int ldb, int K,
                  f32x4 (&acc)[WM][WN], char* smem) {
  constexpr int BM = 64 * WM, BN = 32 * WN;
  constexpr int NA = BM * 8 / NTHREADS, NBC = BN * 8 / NTHREADS;
  constexpr int LP = 72;
  const int tid = opaque_tid(), lane = tid & 63, w = tid >> 6, wr = w >> 1, wc = w & 1;
  const int l15 = lane & 15, quad = lane >> 4;
  u16* sA = (u16*)smem;
  u16* sB = sA + 2 * BM * LP;
  uint4 ra[NA], rb[NBC];
  const int nk = K / 64;
  __syncthreads();
#pragma unroll
  for (int i = 0; i < NA; i++) { int c = tid + NTHREADS * i; ra[i] = *(const uint4*)(A + (size_t)(c >> 3) * lda + (c & 7) * 8); }
#pragma unroll
  for (int i = 0; i < NBC; i++) { int c = tid + NTHREADS * i; rb[i] = *(const uint4*)(Bt + (size_t)(c >> 3) * ldb + (c & 7) * 8); }
#pragma unroll
  for (int i = 0; i < NA; i++) { int c = tid + NTHREADS * i; *(uint4*)(sA + (c >> 3) * LP + (c & 7) * 8) = ra[i]; }
#pragma unroll
  for (int i = 0; i < NBC; i++) { int c = tid + NTHREADS * i; *(uint4*)(sB + (c >> 3) * LP + (c & 7) * 8) = rb[i]; }
  __syncthreads();
  int buf = 0;
  for (int kt = 0; kt < nk; kt++) {
    const bool more = (kt + 1 < nk);
    if (more) {
      const int k0 = (kt + 1) * 64;
#pragma unroll
      for (int i = 0; i < NA; i++) { int c = tid + NTHREADS * i; ra[i] = *(const uint4*)(A + (size_t)(c >> 3) * lda + k0 + (c & 7) * 8); }
#pragma unroll
      for (int i = 0; i < NBC; i++) { int c = tid + NTHREADS * i; rb[i] = *(const uint4*)(Bt + (size_t)(c >> 3) * ldb + k0 + (c & 7) * 8); }
    }
    const u16* cA = sA + buf * BM * LP + (wr * WM * 16 + l15) * LP + quad * 8;
    const u16* cB = sB + buf * BN * LP + (wc * WN * 16 + l15) * LP + quad * 8;
#pragma unroll
    for (int ks = 0; ks < 2; ks++) {
      bf16x8 af[WM], bfr[WN];
#pragma unroll
      for (int m = 0; m < WM; m++) af[m] = ld8(cA + m * 16 * LP + ks * 32);
#pragma unroll
      for (int n = 0; n < WN; n++) bfr[n] = ld8(cB + n * 16 * LP + ks * 32);
#pragma unroll
      for (int m = 0; m < WM; m++)
#pragma unroll
        for (int n = 0; n < WN; n++) acc[m][n] = mfma16(af[m], bfr[n], acc[m][n]);
    }
    if (more) {
      u16* dA = sA + (buf ^ 1) * BM * LP;
      u16* dB = sB + (buf ^ 1) * BN * LP;
#pragma unroll
      for (int i = 0; i < NA; i++) { int c = tid + NTHREADS * i; *(uint4*)(dA + (c >> 3) * LP + (c & 7) * 8) = ra[i]; }
#pragma unroll
      for (int i = 0; i < NBC; i++) { int c = tid + NTHREADS * i; *(uint4*)(dB + (c >> 3) * LP + (c & 7) * 8) = rb[i]; }
    }
    __syncthreads();
    buf ^= 1;
  }
}

DI void phase0(const Params& p, int layer, char* smem) {
  const int tid = opaque_tid(), lane = tid & 63, w = tid >> 6;
  if (layer == 0 && blockIdx.x == 0 && tid < 16) ((int*)(p.ws + OFF_CNT))[tid] = 0;
  const float* src = layer == 0 ? p.x : p.out;
  u16* xb = (u16*)(p.ws + OFF_XB);
  float* rstd = (float*)(p.ws + OFF_RSTD);
  for (int row = blockIdx.x * 8 + w; row < NT; row += gridDim.x * 8) {
    const float4* s4 = (const float4*)(src + (size_t)row * D);
    float4 v[8];
    float ss = 0.f;
#pragma unroll
    for (int i = 0; i < 8; i++) { v[i] = s4[lane + 64 * i]; ss += v[i].x * v[i].x + v[i].y * v[i].y + v[i].z * v[i].z + v[i].w * v[i].w; }
    ss = wave_sum(ss);
    float r = rsqrtf(ss * (1.f / D) + 1e-6f);
    if (lane == 0) rstd[row] = r;
    uint2* d2 = (uint2*)(xb + (size_t)row * D);
#pragma unroll
    for (int i = 0; i < 8; i++) d2[lane + 64 * i] = make_uint2(pack2(v[i].x, v[i].y), pack2(v[i].z, v[i].w));
  }
  float* sT = (float*)smem;
  u16* Wt = (u16*)(p.ws + OFF_WT);
  u16* Wbrt = (u16*)(p.ws + OFF_WBR);
  u16* Woutt = (u16*)(p.ws + OFF_WOUT);
  constexpr int NT_IN = 32 * (NW / 64);
  for (int tile = blockIdx.x; tile < NT_IN + 2048; tile += gridDim.x) {
    const float* s; int ld; u16* dst; int K; int kt, nt; const float* gain = nullptr; int mode;
    if (tile < NT_IN) { kt = tile & 31; nt = tile >> 5; s = p.w_in + (size_t)layer * D * NIN; ld = NIN; dst = Wt; K = 2048; mode = 0; gain = p.norm_gain + layer * D; }
    else if (tile < NT_IN + 1024) { int t2 = tile - NT_IN; int bb = t2 >> 8; int r = t2 & 255; kt = r & 7; nt = r >> 3;
      s = p.w_branch + ((size_t)(layer * 4 + bb)) * 512 * 2048; ld = 2048; dst = Wbrt + (size_t)bb * 2048 * 512; K = 512; mode = 1; }
    else { int t2 = tile - NT_IN - 1024; kt = t2 & 31; nt = t2 >> 5; s = p.w_out + (size_t)layer * D * D; ld = 2048; dst = Woutt; K = 2048; mode = 1; }
    const int k0 = kt * 64, n0 = nt * 64;
    __syncthreads();
#pragma unroll
    for (int i = 0; i < 8; i++) {
      int r = (tid >> 6) + 8 * i, c = tid & 63;
      int np = n0 + c, oc; bool valid = true;
      if (mode == 0) {
        if (np < 6144) oc = np; else if (np < 8192) oc = np + 8; else if (np < 8200) oc = np - 2048;
        else if (np < 8320) { oc = 0; valid = false; } else oc = np - 120;
      } else oc = np;
      float v = valid ? s[(size_t)(k0 + r) * ld + oc] : 0.f;
      if (gain) v *= gain[k0 + r];
      sT[r * 65 + c] = v;
    }
    __syncthreads();
#pragma unroll
    for (int i = 0; i < 4; i++) {
      int nn = (tid >> 5) + 16 * i, kk = (tid & 31) * 2;
      *(unsigned*)(dst + (size_t)(n0 + nn) * K + k0 + kk) = pack2(sT[kk * 65 + nn], sT[(kk + 1) * 65 + nn]);
    }
  }
}

DI void phase1(const Params& p, char* smem) {
  const int tid = opaque_tid(), lane = tid & 63, w = tid >> 6, wr = w >> 1, wc = w & 1, l15 = lane & 15, quad = lane >> 4;
  const u16* xb = (const u16*)(p.ws + OFF_XB);
  const u16* Wt = (const u16*)(p.ws + OFF_WT);
  const float* rstd = (const float*)(p.ws + OFF_RSTD);
  u16* grp = (u16*)(p.ws + OFF_GRP);
  float* bd = (float*)(p.ws + OFF_BD);
  constexpr int NTN = NP1 / 128;
  for (int id = blockIdx.x; id < 128 * NTN; id += gridDim.x) {
    int mg = id / (NTN * 16), rem = id % (NTN * 16);
    int nt = rem >> 4, mt = mg * 16 + (rem & 15);
    int m0 = mt * 256, n0 = nt * 128;
    f32x4 acc[4][4];
#pragma unroll
    for (int m = 0; m < 4; m++)
#pragma unroll
      for (int n = 0; n < 4; n++) acc[m][n] = zero4();
    gemm_tile<4, 4>(xb + (size_t)m0 * D, D, Wt + (size_t)n0 * D, D, D, acc, smem);
    const int g = n0 >> 9;
#pragma unroll
    for (int m = 0; m < 4; m++) {
      const int rbase = m0 + wr * 64 + m * 16 + quad * 4;
      float rs[4];
#pragma unroll
      for (int j = 0; j < 4; j++) rs[j] = rstd[rbase + j];
#pragma unroll
      for (int n = 0; n < 4; n++) {
        const int col = n0 + wc * 64 + n * 16 + l15;
        if (g == 16) {
          if (col - 8192 < 8) {
#pragma unroll
            for (int j = 0; j < 4; j++) bd[(size_t)(rbase + j) * 8 + (col - 8192)] = acc[m][n][j] * rs[j];
          }
        } else if (g == 2 || g == 6) {
          const int b = rbase / T, tl = rbase % T;
          u16* dst = grp + (size_t)g * (SZ_GRP / 2) + ((size_t)(b * 512 + (col & 511))) * T + tl;
          *(uint2*)dst = make_uint2(pack2(acc[m][n][0] * rs[0], acc[m][n][1] * rs[1]), pack2(acc[m][n][2] * rs[2], acc[m][n][3] * rs[3]));
        } else {
          u16* dst = grp + (size_t)g * (SZ_GRP / 2) + (size_t)rbase * 512 + (col & 511);
#pragma unroll
          for (int j = 0; j < 4; j++) dst[(size_t)j * 512] = f2bf(acc[m][n][j] * rs[j]);
        }
      }
    }
  }
}

DI int t5_bucket(int n) {
  if (n < 16) return n;
  float nf = (float)n;
  int large = 16 + (int)(logf(nf / 16.f) / 4.852030263919617f * 16.f);
  return large < 31 ? large : 31;
}

template <int DV, int NMAP, bool IS_A>
DI void attn_item(const Params& p, int layer, int item, char* smem) {
  constexpr int QB = NMAP == 1 ? 256 : 128;
  constexpr int NH = IS_A ? 8 : 4;
  constexpr int HW = 512 / NH;
  constexpr int NDT = DV / 16;
  constexpr int LIM = IS_A ? 2049 : 2048;
  constexpr int LP = 72;
  constexpr int GQ = IS_A ? 0 : 4;
  const int tid = opaque_tid(), lane = tid & 63, w = tid >> 6, l15 = lane & 15, quad = lane >> 4;
  const int nqb = T / QB;
  const int qblk = nqb - 1 - item / (NB * NH);
  const int bh = item % (NB * NH);
  const int b = bh / NH, h = bh % NH;
  const int q0 = qblk * QB;
  float* tab = (float*)smem;
  u16* sK = (u16*)(smem + 8320);
  u16* sV = sK + NMAP * 64 * LP;
  const u16* Qg = (const u16*)(p.ws + OFF_GRP) + (size_t)(GQ + 0) * (SZ_GRP / 2);
  const u16* Kg = (const u16*)(p.ws + OFF_GRP) + (size_t)(GQ + 1) * (SZ_GRP / 2);
  const u16* Vt = (const u16*)(p.ws + OFF_GRP) + (size_t)(GQ + 2) * (SZ_GRP / 2);
  u16* Yg = (u16*)(p.ws + OFF_GRP) + (size_t)(GQ + 3) * (SZ_GRP / 2);

  __syncthreads();
  for (int d = tid; d < 2050; d += NTHREADS) {
    float v;
    if (d == 2049) v = NEG_INF;
    else {
      float bias = p.rel_bias[t5_bucket(d) * 12 + (IS_A ? h : 8 + h)];
      if (IS_A) {
        int m = (d <= 128 ? 1 : 0) + (((d & 3) == 0 && d <= 512) ? 1 : 0) + (((d & 15) == 0) ? 1 : 0);
        v = m ? bias + logf((float)m) : NEG_INF;
      } else v = bias;
    }
    tab[d] = v;
  }
  const int map = NMAP == 2 ? (w >> 2) : 0;
  const int wq = (NMAP == 2 ? (w & 3) : w) * 32;
  bf16x8 qf[2][2];
#pragma unroll
  for (int qt = 0; qt < 2; qt++)
#pragma unroll
    for (int ks = 0; ks < 2; ks++)
      qf[qt][ks] = ld8(Qg + (size_t)(b * T + q0 + wq + qt * 16 + l15) * 512 + h * HW + map * 64 + ks * 32 + quad * 8);

  f32x4 ot[NDT][2];
#pragma unroll
  for (int i = 0; i < NDT; i++) { ot[i][0] = zero4(); ot[i][1] = zero4(); }
  float mrun[2] = {NEG_INF, NEG_INF}, lrun[2] = {0.f, 0.f};

  int lo = IS_A ? (q0 - 2048 > 0 ? q0 - 2048 : 0) : 0;
  const int kt_lo = lo / 64, kt_hi = (q0 + QB) / 64;
  constexpr int NKC = NMAP * 512 / NTHREADS;
  constexpr int NVC = DV * 8 / NTHREADS;
  uint4 rk0, rk1, rv0, rv1;
  rk1 = make_uint4(0,0,0,0); rv1 = rk1;
#define LDK_(i_, dst_) { int c = tid + NTHREADS * (i_); int mc = c >> 9, row = (c & 511) >> 3, kc = c & 7; \
    dst_ = *(const uint4*)(Kg + (size_t)(b * T + s0_ + row) * 512 + h * HW + mc * 64 + kc * 8); }
#define LDV_(i_, dst_) { int c = tid + NTHREADS * (i_); int dv = c >> 3, kc = c & 7; \
    dst_ = *(const uint4*)(Vt + ((size_t)(b * 512 + h * DV + dv)) * T + s0_ + kc * 8); }
#define LOADKV(KT) { const int s0_ = (KT) * 64; LDK_(0, rk0); if (NKC > 1) LDK_(1, rk1); LDV_(0, rv0); if (NVC > 1) LDV_(1, rv1); }
#define STK_(i_, src_) { int c = tid + NTHREADS * (i_); int mc = c >> 9, row = (c & 511) >> 3, kc = c & 7; *(uint4*)(sK + (mc * 64 + row) * LP + kc * 8) = src_; }
#define STV_(i_, src_) { int c = tid + NTHREADS * (i_); int dv = c >> 3, kc = c & 7; *(uint4*)(sV + dv * LP + kc * 8) = src_; }
  LOADKV(kt_lo);
  for (int kt = kt_lo; kt < kt_hi; kt++) {
    __syncthreads();
    STK_(0, rk0); if (NKC > 1) STK_(1, rk1); STV_(0, rv0); if (NVC > 1) STV_(1, rv1);
    __syncthreads();
    if (kt + 1 < kt_hi) LOADKV(kt + 1);
    const int s0 = kt * 64;
    f32x4 st[2][4];
#pragma unroll
    for (int qt = 0; qt < 2; qt++)
#pragma unroll
      for (int k4 = 0; k4 < 4; k4++) st[qt][k4] = zero4();
#pragma unroll
    for (int k4 = 0; k4 < 4; k4++)
#pragma unroll
      for (int ks = 0; ks < 2; ks++) {
        bf16x8 kf = ld8(sK + (map * 64 + k4 * 16 + l15) * LP + ks * 32 + quad * 8);
#pragma unroll
        for (int qt = 0; qt < 2; qt++) st[qt][k4] = mfma16(kf, qf[qt][ks], st[qt][k4]);
      }
    bf16x8 pf[2][2];
#pragma unroll
    for (int qt = 0; qt < 2; qt++) {
      const int qpos = q0 + wq + qt * 16 + l15;
      float mx = NEG_INF;
#pragma unroll
      for (int k4 = 0; k4 < 4; k4++)
#pragma unroll
        for (int j = 0; j < 4; j++) {
          int d = qpos - (s0 + k4 * 16 + quad * 4 + j);
          int di = d < LIM ? d : LIM;
          float s = d < 0 ? NEG_INF : st[qt][k4][j] * 0.125f + tab[di < 0 ? 0 : di];
          st[qt][k4][j] = s;
          mx = fmaxf(mx, s);
        }
      mx = fmaxf(mx, __shfl_xor(mx, 16));
      mx = fmaxf(mx, __shfl_xor(mx, 32));
      const float mnew = fmaxf(mrun[qt], mx);
      const float msafe = (mnew == NEG_INF) ? 0.f : mnew;
      const float alpha = __expf(mrun[qt] - msafe);
      mrun[qt] = mnew;
      float rsum = 0.f;
#pragma unroll
      for (int k4 = 0; k4 < 4; k4++)
#pragma unroll
        for (int j = 0; j < 4; j++) { float e = __expf(st[qt][k4][j] - msafe); st[qt][k4][j] = e; rsum += e; }
      lrun[qt] = lrun[qt] * alpha + rsum;
#pragma unroll
      for (int i = 0; i < NDT; i++) { ot[i][qt][0] *= alpha; ot[i][qt][1] *= alpha; ot[i][qt][2] *= alpha; ot[i][qt][3] *= alpha; }
#pragma unroll
      for (int g = 0; g < 2; g++) {
        bf16x8 t;
#pragma unroll
        for (int j = 0; j < 4; j++) { t[j] = (short)f2bf(st[qt][2 * g][j]); t[4 + j] = (short)f2bf(st[qt][2 * g + 1][j]); }
        pf[qt][g] = t;
      }
    }
#pragma unroll
    for (int g = 0; g < 2; g++)
#pragma unroll
      for (int i = 0; i < NDT; i++) {
        bf16x4 vlo = ld4(sV + (i * 16 + l15) * LP + g * 32 + quad * 4);
        bf16x4 vhi = ld4(sV + (i * 16 + l15) * LP + g * 32 + 16 + quad * 4);
        bf16x8 vf = __builtin_shufflevector(vlo, vhi, 0, 1, 2, 3, 4, 5, 6, 7);
#pragma unroll
        for (int qt = 0; qt < 2; qt++) ot[i][qt] = mfma16(vf, pf[qt][g], ot[i][qt]);
      }
  }
  float inv[2];
#pragma unroll
  for (int qt = 0; qt < 2; qt++) {
    float l = lrun[qt];
    l += __shfl_xor(l, 16);
    l += __shfl_xor(l, 32);
    inv[qt] = 1.f / l;
  }
  if (IS_A) {
#pragma unroll
    for (int qt = 0; qt < 2; qt++) {
      const size_t tok = (size_t)(b * T + q0 + wq + qt * 16 + l15);
#pragma unroll
      for (int i = 0; i < NDT; i++) {
        u16* yp = Yg + tok * 512 + h * DV + i * 16 + quad * 4;
        uint2 gz = *(const uint2*)yp;
        float g0 = bf2f((u16)(gz.x & 0xffff)), g1 = bf2f((u16)(gz.x >> 16)), g2 = bf2f((u16)(gz.y & 0xffff)), g3 = bf2f((u16)(gz.y >> 16));
        float o0 = ot[i][qt][0] * inv[qt] * siluf_(g0), o1 = ot[i][qt][1] * inv[qt] * siluf_(g1);
        float o2 = ot[i][qt][2] * inv[qt] * siluf_(g2), o3 = ot[i][qt][3] * inv[qt] * siluf_(g3);
        *(uint2*)yp = make_uint2(pack2(o0, o1), pack2(o2, o3));
      }
    }
  } else {
    const float* dl = p.diff_lambda + layer * 256;
    float s1 = 0.f, s2 = 0.f;
    for (int i = 0; i < 64; i++) { s1 += dl[i] * dl[64 + i]; s2 += dl[128 + i] * dl[192 + i]; }
    const float lam_init = 0.8f - 0.6f * expf(-0.3f * (float)layer);
    const float lam = expf(s1) - expf(s2) + lam_init;
    float* sO2 = (float*)smem;
    __syncthreads();
    if (map == 1) {
#pragma unroll
      for (int qt = 0; qt < 2; qt++)
#pragma unroll
        for (int i = 0; i < NDT; i++)
#pragma unroll
          for (int j = 0; j < 4; j++) sO2[(wq + qt * 16 + l15) * 132 + i * 16 + quad * 4 + j] = ot[i][qt][j] * inv[qt];
    }
    __syncthreads();
    if (map == 0) {
      const float* sg = p.diff_subln + layer * 128;
#pragma unroll
      for (int qt = 0; qt < 2; qt++) {
        float ss = 0.f;
#pragma unroll
        for (int i = 0; i < NDT; i++)
#pragma unroll
          for (int j = 0; j < 4; j++) {
            float o = ot[i][qt][j] * inv[qt] - lam * sO2[(wq + qt * 16 + l15) * 132 + i * 16 + quad * 4 + j];
            ot[i][qt][j] = o; ss += o * o;
          }
        ss += __shfl_xor(ss, 16);
        ss += __shfl_xor(ss, 32);
        const float r = rsqrtf(ss * (1.f / 128.f) + 1e-6f) * (1.f - lam_init);
        const size_t tok = (size_t)(b * T + q0 + wq + qt * 16 + l15);
#pragma unroll
        for (int i = 0; i < NDT; i++) {
          const int dv = i * 16 + quad * 4;
          u16* yp = Yg + tok * 512 + h * DV + dv;
          uint2 gz = *(const uint2*)yp;
          float g0 = bf2f((u16)(gz.x & 0xffff)), g1 = bf2f((u16)(gz.x >> 16)), g2 = bf2f((u16)(gz.y & 0xffff)), g3 = bf2f((u16)(gz.y >> 16));
          float o0 = ot[i][qt][0] * r * sg[dv + 0] * siluf_(g0), o1 = ot[i][qt][1] * r * sg[dv + 1] * siluf_(g1);
          float o2 = ot[i][qt][2] * r * sg[dv + 2] * siluf_(g2), o3 = ot[i][qt][3] * r * sg[dv + 3] * siluf_(g3);
          *(uint2*)yp = make_uint2(pack2(o0, o1), pack2(o2, o3));
        }
      }
    }
  }
}

DI void c_prepass(const Params& p, int layer, int ci, char* smem) {
  const int tid = opaque_tid(), lane = tid & 63, w = tid >> 6, l15 = lane & 15, quad = lane >> 4;
  const int n = ci & 255, bh = ci >> 8, b = bh >> 2, h = bh & 3;
  const int t0 = n * 64;
  const size_t tok0 = (size_t)b * T + t0;
  u16* sQb = (u16*)smem;
  u16* sKb = sQb + 64 * 136;
  u16* sVbT = sKb + 64 * 136;
  u16* sKbT = sVbT + 128 * 72;
  char* r2 = (char*)(sKbT + 128 * 72);
  u16* sKdT = (u16*)r2;
  float* sM = (float*)r2;
  float* sTm = sM + 64 * 65;
  u16* sTb = (u16*)(sTm + 64 * 65);
  float* sG = (float*)(sTb + 64 * 72);
  float* sBeta = sG + 64;
  const u16* grp = (const u16*)(p.ws + OFF_GRP);
  const u16* cq = grp + (size_t)8 * (SZ_GRP / 2);
  const u16* ck = grp + (size_t)9 * (SZ_GRP / 2);
  const u16* cv = grp + (size_t)10 * (SZ_GRP / 2);
  const float* bd = (const float*)(p.ws + OFF_BD);
  __syncthreads();
  if (w == 0) {
    const float* bdr = bd + (tok0 + lane) * 8;
    float beta = sigmoidf_(bdr[h]);
    float xa = bdr[4 + h] + p.dn_dt_bias[layer * 4 + h];
    float sp = xa > 20.f ? xa : log1pf(expf(xa));
    float g = -expf(p.dn_a_log[layer * 4 + h]) * sp;
#pragma unroll
    for (int o = 1; o < 64; o <<= 1) { float t = __shfl_up(g, o); if (lane >= o) g += t; }
    sG[lane] = g; sBeta[lane] = beta;
  }
  __syncthreads();
  const float Glast = sG[63];
  {
    const float* cw = p.dn_conv + (size_t)layer * 4 * 1536;
    u16* cQ = (u16*)(p.ws + OFF_CQ) + (size_t)ci * 8192;
    for (int ii = 0; ii < 8; ii++) {
      const int i = w * 8 + ii;
      float val[6];
#pragma unroll
      for (int c6 = 0; c6 < 6; c6++) {
        const int part = c6 >> 1, ch = h * 128 + (c6 & 1) * 64 + lane;
        const u16* src = part == 0 ? cq : (part == 1 ? ck : cv);
        float a = 0.f;
#pragma unroll
        for (int j = 0; j < 4; j++) {
          int tl = t0 + i - 3 + j;
          float xin = tl >= 0 ? bf2f(src[((size_t)b * T + tl) * 512 + ch]) : 0.f;
          a += cw[j * 1536 + part * 512 + ch] * xin;
        }
        val[c6] = siluf_(a);
      }
      float sq = wave_sum(val[0] * val[0] + val[1] * val[1]);
      float sk = wave_sum(val[2] * val[2] + val[3] * val[3]);
      const float rq = rsqrtf(sq + 1e-6f) * 0.08838834764831845f, rk = rsqrtf(sk + 1e-6f);
      const float Gi = sG[i], bi = sBeta[i];
      const float eG = __expf(Gi), eGl = __expf(Glast - Gi);
#pragma unroll
      for (int e = 0; e < 2; e++) {
        const int dd = e * 64 + lane;
        const float qn = val[e] * rq, kn = val[2 + e] * rk, vv = val[4 + e];
        sQb[i * 136 + dd] = f2bf(qn);
        sKb[i * 136 + dd] = f2bf(kn);
        sVbT[dd * 72 + i] = f2bf(vv * bi);
        sKbT[dd * 72 + i] = f2bf(kn * bi * eG);
        sKdT[dd * 72 + i] = f2bf(kn * eGl);
        cQ[i * 128 + dd] = f2bf(qn * eG);
      }
    }
  }
  __syncthreads();
  {
    u16* cKd = (u16*)(p.ws + OFF_CKD) + (size_t)ci * 8192;
#pragma unroll
    for (int i = 0; i < 2; i++) { int c = tid + NTHREADS * i; int row = c >> 3, kc = c & 7; *(uint4*)(cKd + row * 64 + kc * 8) = *(const uint4*)(sKdT + row * 72 + kc * 8); }
    if (tid < 128) ((float*)(p.ws + OFF_CDEC))[(size_t)ci * 128 + tid] = __expf(Glast);
  }
  f32x4 akk[2], aqk[2];
#pragma unroll
  for (int tt = 0; tt < 2; tt++) {
    const int tile = w + 8 * tt, rt = tile >> 2, ct = tile & 3;
    akk[tt] = zero4(); aqk[tt] = zero4();
#pragma unroll
    for (int ks = 0; ks < 4; ks++) {
      bf16x8 bk = ld8(sKb + (ct * 16 + l15) * 136 + ks * 32 + quad * 8);
      bf16x8 ak = ld8(sKb + (rt * 16 + l15) * 136 + ks * 32 + quad * 8);
      bf16x8 aq = ld8(sQb + (rt * 16 + l15) * 136 + ks * 32 + quad * 8);
      akk[tt] = mfma16(ak, bk, akk[tt]);
      aqk[tt] = mfma16(aq, bk, aqk[tt]);
    }
  }
  __syncthreads();
  {
    u16* cA = (u16*)(p.ws + OFF_CA) + (size_t)ci * 4096;
#pragma unroll
    for (int tt = 0; tt < 2; tt++) {
      const int tile = w + 8 * tt, rt = tile >> 2, ct = tile & 3;
      const int jc = ct * 16 + l15;
      const float Gj = sG[jc];
#pragma unroll
      for (int j = 0; j < 4; j++) {
        const int ir = rt * 16 + quad * 4 + j;
        const float gam = jc <= ir ? __expf(sG[ir] - Gj) : 0.f;
        sM[ir * 65 + jc] = jc < ir ? sBeta[ir] * akk[tt][j] * gam : 0.f;
        cA[ir * 64 + jc] = f2bf(aqk[tt][j] * gam);
      }
    }
  }
  __syncthreads();
  if (w == 0) {
    const int c = lane;
    for (int i = 0; i < 64; i++) {
      float s = (i == c) ? 1.f : 0.f;
      for (int j = 0; j < i; j++) s -= sM[i * 65 + j] * sTm[j * 65 + c];
      sTm[i * 65 + c] = (i < c) ? 0.f : s;
    }
  }
  __syncthreads();
#pragma unroll
  for (int i = 0; i < 8; i++) { int e = tid + NTHREADS * i; int r = e >> 6, c = e & 63; sTb[r * 72 + c] = f2bf(sTm[r * 65 + c]); }
  __syncthreads();
  {
    u16* cU = (u16*)(p.ws + OFF_CU);
    u16* cW = (u16*)(p.ws + OFF_CW) + (size_t)ci * 8192;
    const int ct = w;
#pragma unroll
    for (int rt = 0; rt < 4; rt++) {
      f32x4 au = zero4(), aw = zero4();
#pragma unroll
      for (int ks = 0; ks < 2; ks++) {
        bf16x8 at = ld8(sTb + (rt * 16 + l15) * 72 + ks * 32 + quad * 8);
        bf16x8 bv = ld8(sVbT + (ct * 16 + l15) * 72 + ks * 32 + quad * 8);
        bf16x8 bk = ld8(sKbT + (ct * 16 + l15) * 72 + ks * 32 + quad * 8);
        au = mfma16(at, bv, au);
        aw = mfma16(at, bk, aw);
      }
#pragma unroll
      for (int j = 0; j < 4; j++) {
        const int ir = rt * 16 + quad * 4 + j;
        cU[(tok0 + ir) * 512 + h * 128 + ct * 16 + l15] = f2bf(au[j]);
        cW[ir * 128 + ct * 16 + l15] = f2bf(aw[j]);
      }
    }
  }
}

DI void d_prepass(const Params& p, int layer, int ci, char* smem) {
  const int tid = opaque_tid(), lane = tid & 63, w = tid >> 6, l15 = lane & 15, quad = lane >> 4;
  const int n = ci & 255, bh = ci >> 8, b = bh >> 2, h = bh & 3;
  const size_t tok0 = (size_t)b * T + n * 64;
  float* sBc = (float*)smem;
  float* sKv = sBc + 64 * 128;
  u16* sQh = (u16*)(sKv + 64 * 128);
  u16* sKh = sQh + 64 * 136;
  u16* sKdT = sKh + 64 * 136;
  float* sPart = (float*)(sKdT + 128 * 72);
  u16* grp = (u16*)(p.ws + OFF_GRP);
  u16* dq = grp + (size_t)12 * (SZ_GRP / 2);
  const u16* df = grp + (size_t)13 * (SZ_GRP / 2);
  __syncthreads();
  const int d = tid & 127, qtr = tid >> 7;
  float lb = 0.f;
  if (layer == 1) lb = sigmoidf_(p.hg_lb_logits[512 + h * 128 + d] - p.hg_lb_logits[h * 128 + d]);
  lb = fminf(fmaxf(lb, 0.f), 1.f);
  {
    float run = 0.f;
    for (int r = 0; r < 16; r++) {
      const int i = qtr * 16 + r;
      float fr = bf2f(df[(tok0 + i) * 512 + h * 128 + d]);
      float kk = (1.f - lb) * sigmoidf_(-fr);
      float lf = log1pf(-kk);
      run += lf;
      sBc[i * 128 + d] = run;
      sKv[i * 128 + d] = kk;
    }
    sPart[qtr * 128 + d] = run;
  }
  __syncthreads();
  {
    float off = 0.f;
    for (int q2 = 0; q2 < qtr; q2++) off += sPart[q2 * 128 + d];
    for (int r = 0; r < 16; r++) sBc[(qtr * 16 + r) * 128 + d] += off;
  }
  __syncthreads();
  {
    const float bl = sBc[63 * 128 + d], bm = sBc[31 * 128 + d];
    for (int r = 0; r < 16; r++) {
      const int i = qtr * 16 + r;
      const float bc = sBc[i * 128 + d], kk = sKv[i * 128 + d];
      u16* qp = dq + (tok0 + i) * 512 + h * 128 + d;
      const float q = bf2f(*qp);
      *qp = f2bf(q * __expf(bc));
      sQh[i * 136 + d] = f2bf(q * __expf(bc - bm));
      sKh[i * 136 + d] = f2bf(kk * __expf(bm - bc));
      sKdT[d * 72 + i] = f2bf(kk * __expf(bl - bc));
    }
    if (qtr == 0) ((float*)(p.ws + OFF_DDEC))[(size_t)ci * 128 + d] = __expf(bl);
  }
  __syncthreads();
  {
    u16* dKd = (u16*)(p.ws + OFF_DKD) + (size_t)ci * 8192;
#pragma unroll
    for (int i = 0; i < 2; i++) { int c = tid + NTHREADS * i; int row = c >> 3, kc = c & 7; *(uint4*)(dKd + row * 64 + kc * 8) = *(const uint4*)(sKdT + row * 72 + kc * 8); }
    u16* dA = (u16*)(p.ws + OFF_DA) + (size_t)ci * 4096;
#pragma unroll
    for (int tt = 0; tt < 2; tt++) {
      const int tile = w + 8 * tt, rt = tile >> 2, ct = tile & 3;
      f32x4 a = zero4();
#pragma unroll
      for (int ks = 0; ks < 4; ks++) {
        bf16x8 aq = ld8(sQh + (rt * 16 + l15) * 136 + ks * 32 + quad * 8);
        bf16x8 bk = ld8(sKh + (ct * 16 + l15) * 136 + ks * 32 + quad * 8);
        a = mfma16(aq, bk, a);
      }
      const int jc = ct * 16 + l15;
#pragma unroll
      for (int j = 0; j < 4; j++) {
        const int ir = rt * 16 + quad * 4 + j;
        dA[ir * 64 + jc] = f2bf(jc <= ir ? a[j] : 0.f);
      }
    }
  }
}

struct ScanRegs {
  bf16x8 wf[4], qf[4], af[2], kdf[2];
  float decv;
  float u[4][4];
};

template <bool DELTA>
DI void scan_load(ScanRegs& r, const u16* U, const u16* W, const u16* Q, int ldq, const u16* KdT, const u16* A, const float* dec,
                  int rt, int cbase, int w, int l15, int quad) {
#pragma unroll
  for (int ks = 0; ks < 4; ks++) {
    if (DELTA) r.wf[ks] = ld8(W + (rt * 16 + l15) * 128 + ks * 32 + quad * 8);
    r.qf[ks] = ld8(Q + (size_t)(rt * 16 + l15) * ldq + ks * 32 + quad * 8);
  }
#pragma unroll
  for (int ks = 0; ks < 2; ks++) {
    r.af[ks] = ld8(A + (rt * 16 + l15) * 64 + ks * 32 + quad * 8);
    r.kdf[ks] = ld8(KdT + (w * 16 + l15) * 64 + ks * 32 + quad * 8);
  }
  r.decv = dec[w * 16 + l15];
#pragma unroll
  for (int c4 = 0; c4 < 4; c4++)
#pragma unroll
    for (int j = 0; j < 4; j++) r.u[c4][j] = bf2f(U[(size_t)(rt * 16 + quad * 4 + j) * 512 + (cbase + c4) * 16 + l15]);
}

template <bool DELTA>
DI void scan_item(const Params& p, int layer, int bh, char* smem) {
  const int tid = opaque_tid(), lane = tid & 63, w = tid >> 6, l15 = lane & 15, quad = lane >> 4;
  const int b = bh >> 2, h = bh & 3;
  u16* sSt = (u16*)smem;
  u16* sVnT = sSt + 128 * 136;
  float* sO = (float*)(sVnT + 128 * 72);
  u16* grp = (u16*)(p.ws + OFF_GRP);
  const u16* Ubase = DELTA ? (const u16*)(p.ws + OFF_CU) : grp + (size_t)14 * (SZ_GRP / 2);
  u16* Ybase = grp + (size_t)(DELTA ? 11 : 15) * (SZ_GRP / 2);
  const float* ngain = DELTA ? p.dn_norm_gain + layer * 128 : p.hg_norm_gain + layer * 128;
  const int rt = w >> 1, cbase = (w & 1) * 4;
  __syncthreads();
  for (int e = tid; e < 128 * 136; e += NTHREADS) sSt[e] = 0;
  f32x4 accS[8];
#pragma unroll
  for (int i = 0; i < 8; i++) accS[i] = zero4();
  const float g0 = ngain[lane], g1 = ngain[64 + lane];
  ScanRegs cur;
  __syncthreads();
  for (int n = 0; n < 256; n++) {
    {
      const size_t ci = (size_t)bh * 256 + n;
      const size_t tok0 = (size_t)b * T + n * 64;
      const u16* U = Ubase + tok0 * 512 + h * 128;
      const u16* Wp = (const u16*)(p.ws + OFF_CW) + ci * 8192;
      const u16* Qp = DELTA ? (const u16*)(p.ws + OFF_CQ) + ci * 8192 : grp + (size_t)12 * (SZ_GRP / 2) + tok0 * 512 + h * 128;
      const u16* Kd = (const u16*)(p.ws + (DELTA ? OFF_CKD : OFF_DKD)) + ci * 8192;
      const u16* Ap = (const u16*)(p.ws + (DELTA ? OFF_CA : OFF_DA)) + ci * 4096;
      const float* dc = (const float*)(p.ws + (DELTA ? OFF_CDEC : OFF_DDEC)) + ci * 128;
      scan_load<DELTA>(cur, U, Wp, Qp, DELTA ? 128 : 512, Kd, Ap, dc, rt, cbase, w, l15, quad);
    }
#pragma unroll
    for (int c4 = 0; c4 < 4; c4++) {
      const int ct = cbase + c4;
      float vn[4];
      if (DELTA) {
        f32x4 a = zero4();
#pragma unroll
        for (int ks = 0; ks < 4; ks++) a = mfma16(cur.wf[ks], ld8(sSt + (ct * 16 + l15) * 136 + ks * 32 + quad * 8), a);
#pragma unroll
        for (int j = 0; j < 4; j++) vn[j] = cur.u[c4][j] - a[j];
      } else {
#pragma unroll
        for (int j = 0; j < 4; j++) vn[j] = cur.u[c4][j];
      }
      *(uint2*)(sVnT + (ct * 16 + l15) * 72 + rt * 16 + quad * 4) = make_uint2(pack2(vn[0], vn[1]), pack2(vn[2], vn[3]));
    }
    __syncthreads();
#pragma unroll
    for (int c4 = 0; c4 < 4; c4++) {
      const int ct = cbase + c4;
      f32x4 a = zero4();
#pragma unroll
      for (int ks = 0; ks < 4; ks++) a = mfma16(cur.qf[ks], ld8(sSt + (ct * 16 + l15) * 136 + ks * 32 + quad * 8), a);
#pragma unroll
      for (int ks = 0; ks < 2; ks++) a = mfma16(cur.af[ks], ld8(sVnT + (ct * 16 + l15) * 72 + ks * 32 + quad * 8), a);
#pragma unroll
      for (int j = 0; j < 4; j++) sO[(rt * 16 + quad * 4 + j) * 132 + ct * 16 + l15] = a[j];
    }
#pragma unroll
    for (int dvt = 0; dvt < 8; dvt++) {
      f32x4 a = accS[dvt];
      a[0] *= cur.decv; a[1] *= cur.decv; a[2] *= cur.decv; a[3] *= cur.decv;
#pragma unroll
      for (int ks = 0; ks < 2; ks++) a = mfma16(ld8(sVnT + (dvt * 16 + l15) * 72 + ks * 32 + quad * 8), cur.kdf[ks], a);
      accS[dvt] = a;
    }
    __syncthreads();
#pragma unroll
    for (int dvt = 0; dvt < 8; dvt++)
#pragma unroll
      for (int j = 0; j < 4; j++) sSt[(dvt * 16 + quad * 4 + j) * 136 + w * 16 + l15] = f2bf(accS[dvt][j]);
    {
      const size_t tok0 = (size_t)b * T + n * 64;
#pragma unroll
      for (int ii = 0; ii < 8; ii++) {
        const int i = w * 8 + ii;
        float v0 = sO[i * 132 + lane], v1 = sO[i * 132 + 64 + lane];
        float ss = wave_sum(v0 * v0 + v1 * v1);
        float r = rsqrtf(ss * (1.f / 128.f) + 1e-6f);
        u16* yp = Ybase + (tok0 + i) * 512 + h * 128;
        float z0 = bf2f(yp[lane]), z1 = bf2f(yp[64 + lane]);
        yp[lane] = f2bf(v0 * r * g0 * siluf_(z0));
        yp[64 + lane] = f2bf(v1 * r * g1 * siluf_(z1));
      }
    }
    __syncthreads();
  }
}

DI void phase3(const Params& p, char* smem) {
  const int tid = opaque_tid(), lane = tid & 63, w = tid >> 6, wr = w >> 1, wc = w & 1, l15 = lane & 15, quad = lane >> 4;
  const u16* xb = (const u16*)(p.ws + OFF_XB);
  const u16* Wt = (const u16*)(p.ws + OFF_WT);
  const u16* Wbrt = (const u16*)(p.ws + OFF_WBR);
  const u16* grp = (const u16*)(p.ws + OFF_GRP);
  const float* rstd = (const float*)(p.ws + OFF_RSTD);
  u16* mixed = (u16*)(p.ws + OFF_MIXED);
  for (int id = blockIdx.x; id < 256 * 16; id += gridDim.x) {
    const int mg = id >> 8, rem = id & 255, nt = rem >> 4, mt = mg * 16 + (rem & 15);
    const int m0 = mt * 128, n0 = nt * 128;
    f32x4 mx[2][4];
#pragma unroll
    for (int m = 0; m < 2; m++)
#pragma unroll
      for (int n = 0; n < 4; n++) mx[m][n] = zero4();
    float rs[2][4];
#pragma unroll
    for (int m = 0; m < 2; m++)
#pragma unroll
      for (int j = 0; j < 4; j++) rs[m][j] = rstd[m0 + wr * 32 + m * 16 + quad * 4 + j];
    for (int bb = 0; bb < 4; bb++) {
      f32x4 g[2][4], yv[2][4];
#pragma unroll
      for (int m = 0; m < 2; m++)
#pragma unroll
        for (int n = 0; n < 4; n++) { g[m][n] = zero4(); yv[m][n] = zero4(); }
      gemm_tile<2, 4>(xb + (size_t)m0 * D, D, Wt + (size_t)(NP1 + bb * 2048 + n0) * D, D, D, g, smem);
      gemm_tile<2, 4>(grp + (size_t)(3 + 4 * bb) * (SZ_GRP / 2) + (size_t)m0 * 512, 512, Wbrt + (size_t)(bb * 2048 + n0) * 512, 512, 512, yv, smem);
#pragma unroll
      for (int m = 0; m < 2; m++)
#pragma unroll
        for (int n = 0; n < 4; n++)
#pragma unroll
          for (int j = 0; j < 4; j++) mx[m][n][j] += sigmoidf_(g[m][n][j] * rs[m][j]) * yv[m][n][j];
    }
#pragma unroll
    for (int m = 0; m < 2; m++)
#pragma unroll
      for (int n = 0; n < 4; n++)
#pragma unroll
        for (int j = 0; j < 4; j++)
          mixed[(size_t)(m0 + wr * 32 + m * 16 + quad * 4 + j) * D + n0 + wc * 64 + n * 16 + l15] = f2bf(mx[m][n][j]);
  }
}

DI void phase4(const Params& p, int layer, char* smem) {
  const int tid = opaque_tid(), lane = tid & 63, w = tid >> 6, wr = w >> 1, wc = w & 1, l15 = lane & 15, quad = lane >> 4;
  const u16* mixed = (const u16*)(p.ws + OFF_MIXED);
  const u16* Woutt = (const u16*)(p.ws + OFF_WOUT);
  const float* xs = layer == 0 ? p.x : p.out;
  for (int id = blockIdx.x; id < 128 * 16; id += gridDim.x) {
    const int mg = id >> 8, rem = id & 255, nt = rem >> 4, mt = mg * 16 + (rem & 15);
    const int m0 = mt * 256, n0 = nt * 128;
    f32x4 acc[4][4];
#pragma unroll
    for (int m = 0; m < 4; m++)
#pragma unroll
      for (int n = 0; n < 4; n++) acc[m][n] = zero4();
    gemm_tile<4, 4>(mixed + (size_t)m0 * D, D, Woutt + (size_t)n0 * D, D, D, acc, smem);
#pragma unroll
    for (int m = 0; m < 4; m++)
#pragma unroll
      for (int n = 0; n < 4; n++)
#pragma unroll
        for (int j = 0; j < 4; j++) {
          const size_t idx = (size_t)(m0 + wr * 64 + m * 16 + quad * 4 + j) * D + n0 + wc * 64 + n * 16 + l15;
          p.out[idx] = xs[idx] + acc[m][n][j];
        }
  }
}

DI void final_norm(const Params& p) {
  const int tid = opaque_tid(), lane = tid & 63, w = tid >> 6;
  for (int row = blockIdx.x * 8 + w; row < NT; row += gridDim.x * 8) {
    float4* s4 = (float4*)(p.out + (size_t)row * D);
    const float4* g4 = (const float4*)p.final_gain;
    float4 v[8];
    float ss = 0.f;
#pragma unroll
    for (int i = 0; i < 8; i++) { v[i] = s4[lane + 64 * i]; ss += v[i].x * v[i].x + v[i].y * v[i].y + v[i].z * v[i].z + v[i].w * v[i].w; }
    ss = wave_sum(ss);
    const float r = rsqrtf(ss * (1.f / D) + 1e-6f);
#pragma unroll
    for (int i = 0; i < 8; i++) {
      float4 g = g4[lane + 64 * i];
      s4[lane + 64 * i] = make_float4(v[i].x * r * g.x, v[i].y * r * g.y, v[i].z * r * g.z, v[i].w * r * g.w);
    }
  }
}

#ifndef PH
#define PH 1023
#endif
#ifndef EN_A
#define EN_A 1
#endif
#ifndef EN_B
#define EN_B 1
#endif
#ifndef EN_C
#define EN_C 1
#endif
#ifndef EN_D
#define EN_D 1
#endif

__global__ void __launch_bounds__(NTHREADS) mega(Params p) {
  extern __shared__ __attribute__((aligned(16))) char smem[];
  cg::grid_group grid = cg::this_grid();
  int* cnt = (int*)(p.ws + OFF_CNT);
  for (int layer = 0; layer < 2; layer++) {
#if PH&1
    phase0(p, layer, smem);
#endif
    grid.sync();
#if PH&2
    phase1(p, smem);
#endif
    grid.sync();
    for (;;) {
      int it = next_item(cnt + layer * 2);
      if (it >= 2048 + 2048 + 1024) break;
#if PH&4
      if (it < 2048) c_prepass(p, layer, it, smem);
#endif
#if PH&8
      if (it >= 2048 && it < 4096) d_prepass(p, layer, it - 2048, smem);
#endif
#if PH&16
      if (it >= 4096) attn_item<64, 1, true>(p, layer, it - 4096, smem);
#endif
    }
    grid.sync();
#if PH&32
    if (blockIdx.x < 8) scan_item<true>(p, layer, blockIdx.x, smem);
#endif
#if PH&64
    if (blockIdx.x >= 8 && blockIdx.x < 16) scan_item<false>(p, layer, blockIdx.x - 8, smem);
#endif
    for (;;) {
      int it = next_item(cnt + layer * 2 + 1);
      if (it >= 1024) break;
#if PH&128
      attn_item<128, 2, false>(p, layer, it, smem);
#endif
    }
    grid.sync();
#if PH&256
    phase3(p, smem);
#endif
    grid.sync();
#if PH&512
    phase4(p, layer, smem);
#endif
    grid.sync();
  }
  final_norm(p);
}

extern "C" void kernel_launch(void* const* d_in, const int* in_sizes, int n_in, void* d_out, int out_size, void* d_ws,
                              size_t ws_size, hipStream_t stream) {
  static int grid_blocks = 0;
  if (!grid_blocks) {
    int dev = 0, cus = 0, per_cu = 0;
    hipGetDevice(&dev);
    hipDeviceGetAttribute(&cus, hipDeviceAttributeMultiprocessorCount, dev);
    hipFuncSetAttribute((const void*)mega, hipFuncAttributeMaxDynamicSharedMemorySize, LDS_BYTES);
    hipOccupancyMaxActiveBlocksPerMultiprocessor(&per_cu, (const void*)mega, NTHREADS, LDS_BYTES);
    if (per_cu < 1) per_cu = 1;
    grid_blocks = cus * per_cu;
    if (ws_size < OFF_END) fprintf(stderr, "kernel_launch: workspace too small: %zu < %zu\n", ws_size, (size_t)OFF_END);
  }
  Params p{};
  p.x = (const float*)d_in[0]; p.norm_gain = (const float*)d_in[1]; p.w_in = (const float*)d_in[2];
  p.rel_bias = (const float*)d_in[3]; p.diff_lambda = (const float*)d_in[4]; p.diff_subln = (const float*)d_in[5];
  p.dn_conv = (const float*)d_in[6]; p.dn_a_log = (const float*)d_in[7]; p.dn_dt_bias = (const float*)d_in[8];
  p.dn_norm_gain = (const float*)d_in[9]; p.hg_lb_logits = (const float*)d_in[10]; p.hg_norm_gain = (const float*)d_in[11];
  p.w_branch = (const float*)d_in[12]; p.w_out = (const float*)d_in[13]; p.final_gain = (const float*)d_in[14];
  p.out = (float*)d_out; p.ws = (char*)d_ws;
  void* args[] = {&p};
  hipError_t e = hipLaunchCooperativeKernel((void*)mega, dim3(grid_blocks), dim3(NTHREADS), args, LDS_BYTES, stream);
  if (e != hipSuccess) fprintf(stderr, "cooperative launch failed: %s (grid %d)\n", hipGetErrorString(e), grid_blocks);
}
```

```cpp
#include <hip/hip_runtime.h>
#include <hip/hip_cooperative_groups.h>
#include <cstdio>
#include <cmath>
namespace cg = cooperative_groups;

#define DI __device__ __forceinline__
typedef unsigned short u16;
using bf16x8 = __attribute__((ext_vector_type(8))) short;
using bf16x4 = __attribute__((ext_vector_type(4))) short;
using f32x4  = __attribute__((ext_vector_type(4))) float;

constexpr int D = 2048, NB = 2, T = 16384, NT = NB * T;
constexpr int NIN = 16392;
constexpr int NP1 = 8448;
constexpr int NW = NP1 + 8192;
constexpr int NTHREADS = 512;
constexpr int LDS_BYTES = 131072;
#define NEG_INF (-INFINITY)

constexpr size_t SZ_WT = (size_t)NW * 2048 * 2;
constexpr size_t SZ_WBR = (size_t)4 * 2048 * 512 * 2;
constexpr size_t SZ_WOUT = (size_t)2048 * 2048 * 2;
constexpr size_t SZ_XB = (size_t)NT * 2048 * 2;
constexpr size_t SZ_GRP = (size_t)NT * 512 * 2;
constexpr size_t SZ_CA = (size_t)2048 * 4096 * 2;
constexpr size_t SZ_DEC = (size_t)2048 * 128 * 4;
constexpr size_t OFF_WT = 0;
constexpr size_t OFF_WBR = OFF_WT + SZ_WT;
constexpr size_t OFF_WOUT = OFF_WBR + SZ_WBR;
constexpr size_t OFF_XB = OFF_WOUT + SZ_WOUT;
constexpr size_t OFF_RSTD = OFF_XB + SZ_XB;
constexpr size_t OFF_GRP = OFF_RSTD + (size_t)NT * 4;
constexpr size_t OFF_BD = OFF_GRP + 16 * SZ_GRP;
constexpr size_t OFF_CU = OFF_BD + (size_t)NT * 8 * 4;
constexpr size_t OFF_CW = OFF_CU + SZ_GRP;
constexpr size_t OFF_CQ = OFF_CW + SZ_GRP;
constexpr size_t OFF_CKD = OFF_CQ + SZ_GRP;
constexpr size_t OFF_CA = OFF_CKD + SZ_GRP;
constexpr size_t OFF_CDEC = OFF_CA + SZ_CA;
constexpr size_t OFF_DKD = OFF_CDEC + SZ_DEC;
constexpr size_t OFF_DA = OFF_DKD + SZ_GRP;
constexpr size_t OFF_DDEC = OFF_DA + SZ_CA;
constexpr size_t OFF_CNT = OFF_DDEC + SZ_DEC;
constexpr size_t OFF_XB8 = OFF_CNT + 256;
constexpr size_t OFF_END = OFF_XB8 + (size_t)NT * 2048;
constexpr size_t OFF_WM8 = OFF_WT + (size_t)NP1 * 2048 * 2;
constexpr size_t OFF_MIXED = OFF_CU;

struct Params {
  const float *x, *norm_gain, *w_in, *rel_bias, *diff_lambda, *diff_subln, *dn_conv, *dn_a_log,
      *dn_dt_bias, *dn_norm_gain, *hg_lb_logits, *hg_norm_gain, *w_branch, *w_out, *final_gain;
  float* out;
  char* ws;
};

DI float bf2f(u16 b) { return __uint_as_float(((unsigned)b) << 16); }
DI u16 f2bf(float x) {
  unsigned u = __float_as_uint(x);
  u += 0x7fffu + ((u >> 16) & 1u);
  return (u16)(u >> 16);
}
DI unsigned pack2(float a, float b) { unsigned r; asm("s_nop 0\n\tv_cvt_pk_bf16_f32 %0, %1, %2" : "=v"(r) : "v"(a), "v"(b)); return r; }
DI unsigned pack2_nop(float a, float b) { unsigned r; asm("s_nop 1\n\tv_cvt_pk_bf16_f32 %0, %1, %2\n\ts_nop 1" : "=v"(r) : "v"(a), "v"(b)); return r; }
DI unsigned pack2_safe(float a, float b) { return (unsigned)f2bf(a) | ((unsigned)f2bf(b) << 16); }
using i32x8 = __attribute__((ext_vector_type(8))) int;
DI unsigned pk_fp8x4(float a, float b, float c, float d) { int r = __builtin_amdgcn_cvt_pk_fp8_f32(a, b, 0, false); r = __builtin_amdgcn_cvt_pk_fp8_f32(c, d, r, true); return (unsigned)r; }
DI float quad_allmax(float x) {
  unsigned u = __float_as_uint(x);
  auto r = __builtin_amdgcn_permlane16_swap(u, u, false, false);
  float m = fmaxf(__uint_as_float(r[0]), __uint_as_float(r[1]));
  u = __float_as_uint(m);
  auto r2 = __builtin_amdgcn_permlane32_swap(u, u, false, false);
  return fmaxf(__uint_as_float(r2[0]), __uint_as_float(r2[1]));
}
DI float quad_allsum(float x) {
  unsigned u = __float_as_uint(x);
  auto r = __builtin_amdgcn_permlane16_swap(u, u, false, false);
  float m = __uint_as_float(r[0]) + __uint_as_float(r[1]);
  u = __float_as_uint(m);
  auto r2 = __builtin_amdgcn_permlane32_swap(u, u, false, false);
  return __uint_as_float(r2[0]) + __uint_as_float(r2[1]);
}
#define ROW_ROR_ADD(v_, n_) v_ += __int_as_float(__builtin_amdgcn_update_dpp(0, __float_as_int(v_), 0x120 + (n_), 0xf, 0xf, false))
DI float wave_sum(float v) {
  ROW_ROR_ADD(v, 8); ROW_ROR_ADD(v, 4); ROW_ROR_ADD(v, 2); ROW_ROR_ADD(v, 1);
  return quad_allsum(v);
}
DI float sigmoidf_(float x) { return __builtin_amdgcn_rcpf(1.f + __expf(-x)); }
DI float siluf_(float x) { return x * __builtin_amdgcn_rcpf(1.f + __expf(-x)); }
DI f32x4 mfma16(bf16x8 a, bf16x8 b, f32x4 c) { return __builtin_amdgcn_mfma_f32_16x16x32_bf16(a, b, c, 0, 0, 0); }
DI bf16x8 ld8(const u16* p) { return *reinterpret_cast<const bf16x8*>(p); }
DI bf16x4 ld4(const u16* p) { return *reinterpret_cast<const bf16x4*>(p); }
DI f32x4 zero4() { f32x4 z = {0.f, 0.f, 0.f, 0.f}; return z; }

typedef __attribute__((address_space(1))) char gchar;
DI char* opaque_ws(char* q) { unsigned long v = (unsigned long)q; asm volatile("" : "+s"(v)); return (char*)(gchar*)v; }
DI int opaque_bid() { int t = blockIdx.x; asm volatile("" : "+s"(t)); return t; }
DI int opaque_tid() { int t = threadIdx.x; asm volatile("" : "+v"(t)); return t; }
__shared__ int s_item;

DI int next_item(int* cnt) {
  __syncthreads();
  if (threadIdx.x == 0) s_item = atomicAdd(cnt, 1);
  __syncthreads();
  return s_item;
}

template <int WM, int WN>
DI void gemm_tile(const u16* __restrict__ A, int lda, const u16* __restrict__ Bt, int ldb, int K,
                  f32x4 (&acc)[WM][WN], char* smem) {
  constexpr int BM = 64 * WM, BN = 32 * WN;
  constexpr int NA = BM * 8 / NTHREADS, NBC = BN * 8 / NTHREADS;
  constexpr int LP = 72;
  const int tid = opaque_tid(), lane = tid & 63, w = tid >> 6, wr = w >> 1, wc = w & 1;
  const int l15 = lane & 15, quad = lane >> 4;
  u16* sA = (u16*)smem;
  u16* sB = sA + 2 * BM * LP;
  uint4 ra0, ra1, ra2, ra3, rb0, rb1;
  ra2 = make_uint4(0, 0, 0, 0); ra3 = ra2;
  static_assert(NBC == 2 && (NA == 2 || NA == 4), "tile config");
  const int nk = K / 64;
#define G_LD(dst_, P_, ld_, i_, k0_) { int c = tid + NTHREADS * (i_); dst_ = *(const uint4*)(P_ + (size_t)(c >> 3) * ld_ + (k0_) + (c & 7) * 8); }
#define G_ST(src_, S_, i_) { int c = tid + NTHREADS * (i_); *(uint4*)(S_ + (c >> 3) * LP + (c & 7) * 8) = src_; }
#define G_LOADALL(k0_) { G_LD(ra0, A, lda, 0, k0_); G_LD(ra1, A, lda, 1, k0_); if (NA > 2) { G_LD(ra2, A, lda, 2, k0_); G_LD(ra3, A, lda, 3, k0_); } \
                         G_LD(rb0, Bt, ldb, 0, k0_); G_LD(rb1, Bt, ldb, 1, k0_); }
#define G_STOREALL(SA_, SB_) { G_ST(ra0, SA_, 0); G_ST(ra1, SA_, 1); if (NA > 2) { G_ST(ra2, SA_, 2); G_ST(ra3, SA_, 3); } G_ST(rb0, SB_, 0); G_ST(rb1, SB_, 1); }
  __syncthreads();
  G_LOADALL(0);
  G_STOREALL(sA, sB);
  __syncthreads();
  int buf = 0;
  for (int kt = 0; kt < nk; kt++) {
    const bool more = (kt + 1 < nk);
    if (more) { const int k0 = (kt + 1) * 64; G_LOADALL(k0); }
    const u16* cA = sA + buf * BM * LP + (wr * WM * 16 + l15) * LP + quad * 8;
    const u16* cB = sB + buf * BN * LP + (wc * WN * 16 + l15) * LP + quad * 8;
#pragma unroll
    for (int ks = 0; ks < 2; ks++) {
      bf16x8 af[WM], bfr[WN];
#pragma unroll
      for (int m = 0; m < WM; m++) af[m] = ld8(cA + m * 16 * LP + ks * 32);
#pragma unroll
      for (int n = 0; n < WN; n++) bfr[n] = ld8(cB + n * 16 * LP + ks * 32);
#pragma unroll
      for (int m = 0; m < WM; m++)
#pragma unroll
        for (int n = 0; n < WN; n++) acc[m][n] = mfma16(af[m], bfr[n], acc[m][n]);
    }
    if (more) {
      u16* dA = sA + (buf ^ 1) * BM * LP;
      u16* dB = sB + (buf ^ 1) * BN * LP;
      G_STOREALL(dA, dB);
    }
    __syncthreads();
    buf ^= 1;
  }
#undef G_LD
#undef G_ST
#undef G_LOADALL
#undef G_STOREALL
}

DI int lds_byte2(int r, int c) {
  int st = (r >> 4) * 2 + (c >> 5), ob = (r & 15) * 64 + (c & 31) * 2;
  return st * 1024 + (ob ^ (((ob >> 9) & 1) << 5));
}
DI void stage_rc2(int b, int& R, int& C) {
  int st = b >> 10, sb = b & 1023, swz = sb ^ (((sb >> 9) & 1) << 5);
  R = (st >> 1) * 16 + swz / 64;
  C = (st & 1) * 32 + (swz % 64) / 2;
}
#define WAIT_V0() asm volatile("s_waitcnt vmcnt(0)" ::: "memory")
#define RAW_BARRIER() do { asm volatile("s_waitcnt lgkmcnt(0)" ::: "memory"); __builtin_amdgcn_s_barrier(); asm volatile("" ::: "memory"); } while (0)

template <int MT, bool SWAP>
DI void gemm_core(const u16* __restrict__ Ab, int lda, const u16* __restrict__ Bb, int ldb, int K,
                  f32x4 (&acc)[MT][4], char* smem) {
  constexpr int TILE_A = MT * 32 * 64 * 2, TILE_B = 256 * 64 * 2, STAGE_B = TILE_A + TILE_B;
  constexpr int GLA = TILE_A / 8192, GLB = 4;
  static_assert(2 * STAGE_B <= LDS_BYTES, "LDS");
  const int tid = opaque_tid(), wid = tid >> 6, lane = tid & 63, wr = wid >> 2, wc = wid & 3, fr = lane & 15, fq = lane >> 4;
  int offA[GLA], offB[GLB];
#pragma unroll
  for (int i = 0; i < GLA; ++i) { int R, C; stage_rc2(wid * 1024 + i * 8192 + lane * 16, R, C); offA[i] = R * lda + C; }
#pragma unroll
  for (int i = 0; i < GLB; ++i) { int R, C; stage_rc2(wid * 1024 + i * 8192 + lane * 16, R, C); offB[i] = R * ldb + C; }
#define G_STAGE(buf, kt) do { \
    _Pragma("unroll") for (int i = 0; i < GLA; ++i) \
      __builtin_amdgcn_global_load_lds((const unsigned*)(Ab + offA[i] + (kt) * 64), (__attribute__((address_space(3))) unsigned*)(smem + (buf) * STAGE_B + wid * 1024 + i * 8192), 16, 0, 0); \
    _Pragma("unroll") for (int i = 0; i < GLB; ++i) \
      __builtin_amdgcn_global_load_lds((const unsigned*)(Bb + offB[i] + (kt) * 64), (__attribute__((address_space(3))) unsigned*)(smem + (buf) * STAGE_B + TILE_A + wid * 1024 + i * 8192), 16, 0, 0); \
  } while (0)
  const int nt = K / 64;
  __syncthreads();
  G_STAGE(0, 0);
  WAIT_V0();
  __syncthreads();
  for (int t = 0; t < nt; ++t) {
    const int cur = t & 1;
    if (t + 1 < nt) G_STAGE(cur ^ 1, t + 1);
    const char* sa = smem + cur * STAGE_B;
    const char* sb = sa + TILE_A;
#pragma unroll
    for (int ks = 0; ks < 2; ++ks) {
      bf16x8 At[MT], Bf[4];
#pragma unroll
      for (int m = 0; m < MT; ++m) At[m] = *(const bf16x8*)(sa + lds_byte2(wr * (MT * 16) + m * 16 + fr, ks * 32 + fq * 8));
#pragma unroll
      for (int n = 0; n < 4; ++n) Bf[n] = *(const bf16x8*)(sb + lds_byte2(wc * 64 + n * 16 + fr, ks * 32 + fq * 8));
      __builtin_amdgcn_s_setprio(1);
#pragma unroll
      for (int m = 0; m < MT; ++m)
#pragma unroll
        for (int n = 0; n < 4; ++n) acc[m][n] = SWAP ? mfma16(Bf[n], At[m], acc[m][n]) : mfma16(At[m], Bf[n], acc[m][n]);
      __builtin_amdgcn_s_setprio(0);
      __builtin_amdgcn_sched_barrier(0);
    }
    WAIT_V0();
    __syncthreads();
  }
#undef G_STAGE
}


template <bool SWAP>
DI void gemm_core8(const u16* __restrict__ Ab, const u16* __restrict__ Bb, f32x4 (&acc)[4][4], char* smem) {
  constexpr int MT = 4, lda = 1024, ldb = 1024;
  constexpr int TILE_A = MT * 32 * 64 * 2, TILE_B = 256 * 64 * 2, STAGE_B = TILE_A + TILE_B;
  constexpr int GLA = TILE_A / 8192, GLB = 4;
  const int tid = opaque_tid(), wid = tid >> 6, lane = tid & 63, wr = wid >> 2, wc = wid & 3, fr = lane & 15, fq = lane >> 4;
  int offA[GLA], offB[GLB];
#pragma unroll
  for (int i = 0; i < GLA; ++i) { int R, C; stage_rc2(wid * 1024 + i * 8192 + lane * 16, R, C); offA[i] = R * lda + C; }
#pragma unroll
  for (int i = 0; i < GLB; ++i) { int R, C; stage_rc2(wid * 1024 + i * 8192 + lane * 16, R, C); offB[i] = R * ldb + C; }
#define G_STAGE(buf, kt) do { \
    _Pragma("unroll") for (int i = 0; i < GLA; ++i) \
      __builtin_amdgcn_global_load_lds((const unsigned*)(Ab + offA[i] + (kt) * 64), (__attribute__((address_space(3))) unsigned*)(smem + (buf) * STAGE_B + wid * 1024 + i * 8192), 16, 0, 0); \
    _Pragma("unroll") for (int i = 0; i < GLB; ++i) \
      __builtin_amdgcn_global_load_lds((const unsigned*)(Bb + offB[i] + (kt) * 64), (__attribute__((address_space(3))) unsigned*)(smem + (buf) * STAGE_B + TILE_A + wid * 1024 + i * 8192), 16, 0, 0); \
  } while (0)
  constexpr int nt = 2048 / 128;
  __syncthreads();
  G_STAGE(0, 0);
  WAIT_V0();
  __syncthreads();
  for (int t = 0; t < nt; ++t) {
    const int cur = t & 1;
    if (t + 1 < nt) G_STAGE(cur ^ 1, t + 1);
    const char* sa = smem + cur * STAGE_B;
    const char* sb = sa + TILE_A;
    i32x8 At[MT];
#pragma unroll
    for (int m = 0; m < MT; ++m) {
      const uint4 lo = *(const uint4*)(sa + lds_byte2(wr * (MT * 16) + m * 16 + fr, fq * 16));
      const uint4 hi = *(const uint4*)(sa + lds_byte2(wr * (MT * 16) + m * 16 + fr, fq * 16 + 8));
      i32x8 t8 = {(int)lo.x, (int)lo.y, (int)lo.z, (int)lo.w, (int)hi.x, (int)hi.y, (int)hi.z, (int)hi.w};
      At[m] = t8;
    }
#pragma unroll
    for (int n = 0; n < 4; ++n) {
      const uint4 lo = *(const uint4*)(sb + lds_byte2(wc * 64 + n * 16 + fr, fq * 16));
      const uint4 hi = *(const uint4*)(sb + lds_byte2(wc * 64 + n * 16 + fr, fq * 16 + 8));
      const i32x8 Bf = {(int)lo.x, (int)lo.y, (int)lo.z, (int)lo.w, (int)hi.x, (int)hi.y, (int)hi.z, (int)hi.w};
      __builtin_amdgcn_s_setprio(1);
#pragma unroll
      for (int m = 0; m < MT; ++m)
        acc[m][n] = SWAP ? __builtin_amdgcn_mfma_scale_f32_16x16x128_f8f6f4(Bf, At[m], acc[m][n], 0, 0, 0, 0x7F7F7F7F, 0, 0x7F7F7F7F)
                         : __builtin_amdgcn_mfma_scale_f32_16x16x128_f8f6f4(At[m], Bf, acc[m][n], 0, 0, 0, 0x7F7F7F7F, 0, 0x7F7F7F7F);
      __builtin_amdgcn_s_setprio(0);
    }
    __builtin_amdgcn_sched_barrier(0);
    WAIT_V0();
    __syncthreads();
  }
#undef G_STAGE
}

DI void phase0(const Params& p, int layer, char* smem) {
  const int tid = opaque_tid(), lane = tid & 63, w = tid >> 6;
  char* const WS = opaque_ws(p.ws);
  const int BID = opaque_bid(); (void)BID;
  if (layer == 0 && BID == 0 && tid < 16) ((int*)(WS + OFF_CNT))[tid] = 0;
  if (BID == 0 && w == 0) {
    const float* dl = p.diff_lambda + layer * 256;
    const float s1 = wave_sum(dl[lane] * dl[64 + lane]), s2 = wave_sum(dl[128 + lane] * dl[192 + lane]);
    if (lane == 0) ((float*)(WS + OFF_CNT))[32 + layer] = expf(s1) - expf(s2) + (0.8f - 0.6f * expf(-0.3f * (float)layer));
  }
  const float* src = layer == 0 ? p.x : p.out;
  u16* xb = (u16*)(WS + OFF_XB);
  float* rstd = (float*)(WS + OFF_RSTD);
  for (int row = BID * 8 + w; row < NT; row += gridDim.x * 8) {
    const float4* s4 = (const float4*)(src + (size_t)row * D);
    float4 v[8];
    float ss = 0.f;
#pragma unroll
    for (int i = 0; i < 8; i++) { v[i] = s4[lane + 64 * i]; ss += v[i].x * v[i].x + v[i].y * v[i].y + v[i].z * v[i].z + v[i].w * v[i].w; }
    ss = wave_sum(ss);
    float r = rsqrtf(ss * (1.f / D) + 1e-6f);
    if (lane == 0) rstd[row] = r;
    uint2* d2 = (uint2*)(xb + (size_t)row * D);
#pragma unroll
    for (int i = 0; i < 8; i++) d2[lane + 64 * i] = make_uint2(pack2(v[i].x, v[i].y), pack2(v[i].z, v[i].w));
    unsigned* d8 = (unsigned*)(WS + OFF_XB8 + (size_t)row * D);
#pragma unroll
    for (int i = 0; i < 8; i++) d8[lane + 64 * i] = pk_fp8x4(v[i].x, v[i].y, v[i].z, v[i].w);
  }
  float* sT = (float*)smem;
  u16* Wt = (u16*)(WS + OFF_WT);
  u16* Wbrt = (u16*)(WS + OFF_WBR);
  u16* Woutt = (u16*)(WS + OFF_WOUT);
  constexpr int NT_IN = 32 * (NW / 256);
  for (int tile = BID; tile < NT_IN + 512; tile += gridDim.x) {
    const float* s; int ld; u16* dst; int K; int kt, nt; const float* gain = nullptr; int mode;
    if (tile < NT_IN) { kt = tile & 31; nt = tile >> 5; s = p.w_in + (size_t)layer * D * NIN; ld = NIN; dst = Wt; K = 2048; mode = 0; gain = p.norm_gain + layer * D; }
    else if (tile < NT_IN + 256) { int t2 = tile - NT_IN; int bb = t2 >> 6; int r = t2 & 63; kt = r & 7; nt = r >> 3;
      s = p.w_branch + ((size_t)(layer * 4 + bb)) * 512 * 2048; ld = 2048; dst = Wbrt + (size_t)bb * 2048 * 512; K = 512; mode = 1; }
    else { int t2 = tile - NT_IN - 256; kt = t2 & 31; nt = t2 >> 5; s = p.w_out + (size_t)layer * D * D; ld = 2048; dst = Woutt; K = 2048; mode = 1; }
    const int k0 = kt * 64, n0 = nt * 256;
    __syncthreads();
    {
      const int c4 = (tid & 63) * 4;
      const int np = n0 + c4;
      int oc; bool valid = true;
      if (mode == 0) {
        if (np < 6144) oc = np; else if (np < 8192) oc = np + 8; else if (np < 8200) oc = np - 2048;
        else if (np < 8448) { oc = 0; valid = false; } else oc = np - 248;
      } else oc = np;
#pragma unroll
      for (int i = 0; i < 8; i++) {
        const int r = (tid >> 6) + 8 * i;
        float4 v = valid ? *(const float4*)(s + (size_t)(k0 + r) * ld + oc) : make_float4(0.f, 0.f, 0.f, 0.f);
        if (gain) { const float gg = gain[k0 + r]; v.x *= gg; v.y *= gg; v.z *= gg; v.w *= gg; }
        float* dstl = sT + r * 257 + c4;
        dstl[0] = v.x; dstl[1] = v.y; dstl[2] = v.z; dstl[3] = v.w;
      }
    }
    __syncthreads();
    if (mode == 0 && n0 >= NP1) {
      const int nn = tid & 255, kh = (tid >> 8) * 32;
      unsigned char* d8 = (unsigned char*)(WS + OFF_WM8) + (size_t)(n0 - NP1 + nn) * 2048 + k0 + kh;
#pragma unroll
      for (int q4 = 0; q4 < 2; q4++) {
        unsigned u[4];
#pragma unroll
        for (int e = 0; e < 4; e++) {
          const int kb = kh + q4 * 16 + e * 4;
          u[e] = pk_fp8x4(sT[kb * 257 + nn] * 64.f, sT[(kb + 1) * 257 + nn] * 64.f, sT[(kb + 2) * 257 + nn] * 64.f, sT[(kb + 3) * 257 + nn] * 64.f);
        }
        *(uint4*)(d8 + q4 * 16) = make_uint4(u[0], u[1], u[2], u[3]);
      }
    } else {
      const int nn = tid & 255, kh = (tid >> 8) * 32;
      u16* drow = dst + (size_t)(n0 + nn) * K + k0 + kh;
#pragma unroll
      for (int q4 = 0; q4 < 4; q4++) {
        unsigned u[4];
#pragma unroll
        for (int e = 0; e < 4; e++) u[e] = pack2(sT[(kh + q4 * 8 + 2 * e) * 257 + nn], sT[(kh + q4 * 8 + 2 * e + 1) * 257 + nn]);
        *(uint4*)(drow + q4 * 8) = make_uint4(u[0], u[1], u[2], u[3]);
      }
    }
  }
}

DI void phase1(const Params& p, char* smem) {
  const int tid = opaque_tid(), lane = tid & 63, w = tid >> 6, wr = w >> 2, wc = w & 3, l15 = lane & 15, quad = lane >> 4;
  char* const WS = opaque_ws(p.ws);
  const int BID = opaque_bid(); (void)BID;
  const u16* xb = (const u16*)(WS + OFF_XB);
  const u16* Wt = (const u16*)(WS + OFF_WT);
  const float* rstd = (const float*)(WS + OFF_RSTD);
  u16* grp = (u16*)(WS + OFF_GRP);
  float* bd = (float*)(WS + OFF_BD);
  constexpr int NTN = NP1 / 256;
  int bstart = BID;
  if (gridDim.x == 256) { const int x = BID & 7, j = BID >> 3; bstart = (((x >> 2) * 8 + (j >> 2)) << 4) + (x & 3) * 4 + (j & 3); }
  for (int id = bstart; id < 128 * NTN; id += gridDim.x) {
    int mg = id / (NTN * 16), rem = id % (NTN * 16);
    int nt = rem >> 4, mt = mg * 16 + (rem & 15);
    int m0 = mt * 256, n0 = nt * 256;
    f32x4 acc[8][4];
#pragma unroll
    for (int m = 0; m < 8; m++)
#pragma unroll
      for (int n = 0; n < 4; n++) acc[m][n] = zero4();
    const int g = n0 >> 9;
    if (g == 2 || g == 6 || g == 14) {
      gemm_core<8, false>(xb + (size_t)m0 * D, D, Wt + (size_t)n0 * D, D, D, acc, smem);
#pragma unroll
      for (int m = 0; m < 8; m++) {
        const int rbase = m0 + wr * 128 + m * 16 + quad * 4;
        const float4 rv = *(const float4*)(rstd + rbase);
        const int b = rbase / T, tl = rbase % T;
#pragma unroll
        for (int n = 0; n < 4; n++) {
          const int col = n0 + wc * 64 + n * 16 + l15;
          u16* dst = grp + (size_t)g * (SZ_GRP / 2) + ((size_t)(b * 512 + (col & 511))) * T + tl;
          *(uint2*)dst = make_uint2(pack2(acc[m][n][0] * rv.x, acc[m][n][1] * rv.y), pack2(acc[m][n][2] * rv.z, acc[m][n][3] * rv.w));
        }
      }
    } else {
      gemm_core<8, true>(xb + (size_t)m0 * D, D, Wt + (size_t)n0 * D, D, D, acc, smem);
#pragma unroll
      for (int m = 0; m < 8; m++) {
        const int row = m0 + wr * 128 + m * 16 + l15;
        const float rs = rstd[row];
#pragma unroll
        for (int n = 0; n < 4; n++) {
          const int col4 = n0 + wc * 64 + n * 16 + quad * 4;
          if (g == 16) {
            if (col4 - 8192 < 8) *(float4*)(bd + (size_t)row * 8 + (col4 - 8192)) = make_float4(acc[m][n][0] * rs, acc[m][n][1] * rs, acc[m][n][2] * rs, acc[m][n][3] * rs);
          } else {
            u16* dst = grp + (size_t)g * (SZ_GRP / 2) + (size_t)row * 512 + (col4 & 511);
            *(uint2*)dst = make_uint2(pack2(acc[m][n][0] * rs, acc[m][n][1] * rs), pack2(acc[m][n][2] * rs, acc[m][n][3] * rs));
          }
        }
      }
    }
  }
}

DI int t5_bucket(int n) {
  if (n < 16) return n;
  float nf = (float)n;
  int large = 16 + (int)(logf(nf / 16.f) / 4.852030263919617f * 16.f);
  return large < 31 ? large : 31;
}


template <int NDT>
DI void pv_accum(f32x4 (&ot)[NDT][2], const bf16x8 (&pf)[2][2], const u16* sV, int l15, int quad) {
  constexpr int LP = 72;
#pragma unroll
  for (int g = 0; g < 2; g++) {
    bf16x8 vf[NDT];
#pragma unroll
    for (int i = 0; i < NDT; i++) {
      bf16x4 vlo = ld4(sV + (i * 16 + l15) * LP + g * 32 + quad * 4);
      bf16x4 vhi = ld4(sV + (i * 16 + l15) * LP + g * 32 + 16 + quad * 4);
      vf[i] = __builtin_shufflevector(vlo, vhi, 0, 1, 2, 3, 4, 5, 6, 7);
    }
    __builtin_amdgcn_sched_barrier(0);
#pragma unroll
    for (int i = 0; i < NDT; i++)
#pragma unroll
      for (int qt = 0; qt < 2; qt++) ot[i][qt] = mfma16(vf[i], pf[qt][g], ot[i][qt]);
    __builtin_amdgcn_sched_barrier(0);
  }
}
template <int DV, int NMAP, bool IS_A>
DI void attn_item(const Params& p, int layer, int item, char* smem) {
  constexpr int QB = NMAP == 1 ? 256 : 128;
  constexpr int NH = IS_A ? 8 : 4;
  constexpr int HW = 512 / NH;
  constexpr int NDT = DV / 16;
  constexpr int LIM = IS_A ? 2049 : 2048;
  constexpr int LP = 72;
  constexpr int GQ = IS_A ? 0 : 4;
  const int tid = opaque_tid(), lane = tid & 63, w = tid >> 6, l15 = lane & 15, quad = lane >> 4;
  char* const WS = opaque_ws(p.ws);
  const int BID = opaque_bid(); (void)BID;
  const int nqb = T / QB;
  const int qblk = nqb - 1 - item / (NB * NH);
  const int bh = item % (NB * NH);
  const int b = bh / NH, h = bh % NH;
  const int q0 = qblk * QB;
  float* tab = (float*)smem;
  u16* sK = (u16*)(smem + 8320);
  const u16* Qg = (const u16*)(WS + OFF_GRP) + (size_t)(GQ + 0) * (SZ_GRP / 2);
  const u16* Kg = (const u16*)(WS + OFF_GRP) + (size_t)(GQ + 1) * (SZ_GRP / 2);
  const u16* Vt = (const u16*)(WS + OFF_GRP) + (size_t)(GQ + 2) * (SZ_GRP / 2);
  u16* Yg = (u16*)(WS + OFF_GRP) + (size_t)(GQ + 3) * (SZ_GRP / 2);

  __syncthreads();
  for (int d = tid; d < 2050; d += NTHREADS) {
    float v;
    if (d == 2049) v = NEG_INF;
    else {
      float bias = p.rel_bias[t5_bucket(d) * 12 + (IS_A ? h : 8 + h)];
      if (IS_A) {
        int m = (d <= 128 ? 1 : 0) + (((d & 3) == 0 && d <= 512) ? 1 : 0) + (((d & 15) == 0) ? 1 : 0);
        v = m ? bias + logf((float)m) : NEG_INF;
      } else v = bias;
    }
    tab[d] = v;
  }
  const int map = NMAP == 2 ? (w >> 2) : 0;
  const int wq = (NMAP == 2 ? (w & 3) : w) * 32;
  bf16x8 qf[2][2];
#pragma unroll
  for (int qt = 0; qt < 2; qt++)
#pragma unroll
    for (int ks = 0; ks < 2; ks++)
      qf[qt][ks] = ld8(Qg + (size_t)(b * T + q0 + wq + qt * 16 + l15) * 512 + h * HW + map * 64 + ks * 32 + quad * 8);

  f32x4 ot[NDT][2];
#pragma unroll
  for (int i = 0; i < NDT; i++) { ot[i][0] = zero4(); ot[i][1] = zero4(); }
  float mrun[2] = {NEG_INF, NEG_INF}, lrun[2] = {0.f, 0.f};

  int lo = IS_A ? (q0 - 2048 > 0 ? q0 - 2048 : 0) : 0;
  const int kt_lo = lo / 64, kt_hi = (q0 + QB) / 64;
  constexpr int NKC = NMAP * 512 / NTHREADS;
  constexpr int NVC = DV * 8 / NTHREADS;
  uint4 rk0, rk1, rv0, rv1;
  rk1 = make_uint4(0,0,0,0); rv1 = rk1;
  const u16 *pk0, *pk1, *pv0, *pv1;
  { int c = tid; int mc = c >> 9, row = (c & 511) >> 3, kc = c & 7;
    pk0 = Kg + (size_t)(b * T + row) * 512 + h * HW + mc * 64 + kc * 8;
    c = tid + NTHREADS; mc = c >> 9; row = (c & 511) >> 3; kc = c & 7;
    pk1 = Kg + (size_t)(b * T + row) * 512 + h * HW + mc * 64 + kc * 8;
    c = tid; int dv = c >> 3; kc = c & 7;
    pv0 = Vt + ((size_t)(b * 512 + h * DV + dv)) * T + kc * 8;
    c = tid + NTHREADS; dv = c >> 3; kc = c & 7;
    pv1 = Vt + ((size_t)(b * 512 + h * DV + dv)) * T + kc * 8; }
#define LOADKV(KT) { const size_t s0_ = (size_t)(KT) * 64; rk0 = *(const uint4*)(pk0 + s0_ * 512); if (NKC > 1) rk1 = *(const uint4*)(pk1 + s0_ * 512); \
                     rv0 = *(const uint4*)(pv0 + s0_); if (NVC > 1) rv1 = *(const uint4*)(pv1 + s0_); }
  constexpr int KST = NMAP * 64 * LP;
  constexpr int VST = DV * LP;
#define STK_(i_, src_) { int c = tid + NTHREADS * (i_); int mc = c >> 9, row = (c & 511) >> 3, kc = c & 7; *(uint4*)(sKw + (mc * 64 + row) * LP + kc * 8) = src_; }
#define STV_(i_, src_) { int c = tid + NTHREADS * (i_); int dv = c >> 3, kc = c & 7; *(uint4*)(sVw + dv * LP + kc * 8) = src_; }
#define STOREKV(ks_, vs_) { u16* sKw = sK0 + (ks_) * KST; u16* sVw = sV0 + (vs_) * VST; STK_(0, rk0); if (NKC > 1) STK_(1, rk1); STV_(0, rv0); if (NVC > 1) STV_(1, rv1); }
  u16* const sK0 = sK;
  u16* const sV0 = sK + 2 * KST;
  const bool late = (NMAP == 2) && (map == 1);
  LOADKV(kt_lo);
  STOREKV(0, 0);
  if (kt_lo + 1 < kt_hi) LOADKV(kt_lo + 1);
  RAW_BARRIER();
  int kcur = 0, vcur = 0, vprev = 0;
  bf16x8 pf[2][2];
#pragma unroll
  for (int a_ = 0; a_ < 2; a_++)
#pragma unroll
    for (int b_ = 0; b_ < 2; b_++) { bf16x8 z8 = {0, 0, 0, 0, 0, 0, 0, 0}; pf[a_][b_] = z8; }
  for (int kt = kt_lo; kt < kt_hi; kt++) {
    const u16* sK = sK0 + kcur * KST;
    const u16* sV = sV0 + vcur * VST;
    if (late && kt > kt_lo) pv_accum<NDT>(ot, pf, sV0 + vprev * VST, l15, quad);
    const int s0 = kt * 64;
    f32x4 st[2][4];
#pragma unroll
    for (int qt = 0; qt < 2; qt++)
#pragma unroll
      for (int k4 = 0; k4 < 4; k4++) st[qt][k4] = zero4();
    {
      bf16x8 kf[4][2];
#pragma unroll
      for (int k4 = 0; k4 < 4; k4++)
#pragma unroll
        for (int ks = 0; ks < 2; ks++) kf[k4][ks] = ld8(sK + (map * 64 + k4 * 16 + l15) * LP + ks * 32 + quad * 8);
      __builtin_amdgcn_sched_barrier(0);
#pragma unroll
      for (int k4 = 0; k4 < 4; k4++)
#pragma unroll
        for (int ks = 0; ks < 2; ks++)
#pragma unroll
          for (int qt = 0; qt < 2; qt++) st[qt][k4] = mfma16(kf[k4][ks], qf[qt][ks], st[qt][k4]);
      __builtin_amdgcn_sched_barrier(0);
    }
    float alpha[2];
    const bool far = !IS_A && (s0 + 63 + 2048 <= q0);
    const bool sparse4 = IS_A && (q0 - s0 - 63 > 128);
    if (far) {
      const float cb = tab[2048];
#pragma unroll
      for (int qt = 0; qt < 2; qt++) {
        float mx = NEG_INF;
#pragma unroll
        for (int k4 = 0; k4 < 4; k4++)
#pragma unroll
          for (int j = 0; j < 4; j++) mx = fmaxf(mx, st[qt][k4][j]);
        mx = quad_allmax(mx);
        const float mnew = fmaxf(mrun[qt], mx * 0.125f + cb);
        alpha[qt] = __builtin_amdgcn_exp2f((mrun[qt] - mnew) * 1.4426950408889634f);
        mrun[qt] = mnew;
        const float c2 = (cb - mnew) * 1.4426950408889634f;
        float rsum = 0.f;
#pragma unroll
        for (int k4 = 0; k4 < 4; k4++)
#pragma unroll
          for (int j = 0; j < 4; j++) { float e = __builtin_amdgcn_exp2f(fmaf(st[qt][k4][j], 0.125f * 1.4426950408889634f, c2)); st[qt][k4][j] = e; rsum += e; }
        lrun[qt] = lrun[qt] * alpha[qt] + rsum;
      }
    } else if (sparse4) {
      const int jsel = l15 & 3;
#pragma unroll
      for (int qt = 0; qt < 2; qt++) {
        const int dbase = q0 + wq + qt * 16 + l15 - s0 - quad * 4 - jsel;
        float cand[4];
        float mx = NEG_INF;
#pragma unroll
        for (int k4 = 0; k4 < 4; k4++) {
          float e01 = (jsel & 1) ? st[qt][k4][1] : st[qt][k4][0];
          float e23 = (jsel & 1) ? st[qt][k4][3] : st[qt][k4][2];
          float e = (jsel & 2) ? e23 : e01;
          int d = dbase - k4 * 16;
          int di = d < LIM ? d : LIM;
          float sv = e * 0.125f + tab[di];
          cand[k4] = sv;
          mx = fmaxf(mx, sv);
        }
        mx = quad_allmax(mx);
        const float mnew = fmaxf(mrun[qt], mx);
        const float msafe = (mnew == NEG_INF) ? 0.f : mnew;
        alpha[qt] = __expf(mrun[qt] - msafe);
        mrun[qt] = mnew;
        float rsum = 0.f;
        unsigned pu[4][2];
#pragma unroll
        for (int k4 = 0; k4 < 4; k4++) {
          float e = __expf(cand[k4] - msafe);
          rsum += e;
          unsigned pb = pack2_nop(e, 0.f) << ((jsel & 1) * 16);
          pu[k4][0] = (jsel & 2) ? 0u : pb;
          pu[k4][1] = (jsel & 2) ? pb : 0u;
        }
        lrun[qt] = lrun[qt] * alpha[qt] + rsum;
#pragma unroll
        for (int g = 0; g < 2; g++) {
          uint4 uu = make_uint4(pu[2 * g][0], pu[2 * g][1], pu[2 * g + 1][0], pu[2 * g + 1][1]);
          pf[qt][g] = __builtin_bit_cast(bf16x8, uu);
        }
      }
    } else {
#pragma unroll
      for (int qt = 0; qt < 2; qt++) {
        const int dq = q0 + wq + qt * 16 + l15 - s0 - quad * 4;
        float mx = NEG_INF;
#pragma unroll
        for (int k4 = 0; k4 < 4; k4++) {
          float tv[4];
#pragma unroll
          for (int j = 0; j < 4; j++) {
            int d = dq - k4 * 16 - j;
            d = d < 0 ? 0 : d;
            tv[j] = tab[d < LIM ? d : LIM];
          }
#pragma unroll
          for (int j = 0; j < 4; j++) {
            const int d = dq - k4 * 16 - j;
            float sv = fmaf(st[qt][k4][j], 0.125f, tv[j]);
            sv = d < 0 ? NEG_INF : sv;
            st[qt][k4][j] = sv;
            mx = fmaxf(mx, sv);
          }
        }
        mx = quad_allmax(mx);
        const float mnew = fmaxf(mrun[qt], mx);
        const float msafe = (mnew == NEG_INF) ? 0.f : mnew;
        alpha[qt] = __expf(mrun[qt] - msafe);
        mrun[qt] = mnew;
        float rsum = 0.f;
#pragma unroll
        for (int k4 = 0; k4 < 4; k4++)
#pragma unroll
          for (int j = 0; j < 4; j++) { float e = __expf(st[qt][k4][j] - msafe); st[qt][k4][j] = e; rsum += e; }
        lrun[qt] = lrun[qt] * alpha[qt] + rsum;
      }
    }
    if (__any((alpha[0] != 1.f) || (alpha[1] != 1.f))) {
#pragma unroll
      for (int qt = 0; qt < 2; qt++)
#pragma unroll
        for (int i = 0; i < NDT; i++) { ot[i][qt][0] *= alpha[qt]; ot[i][qt][1] *= alpha[qt]; ot[i][qt][2] *= alpha[qt]; ot[i][qt][3] *= alpha[qt]; }
    }
    if (!sparse4)
#pragma unroll
    for (int qt = 0; qt < 2; qt++)
#pragma unroll
      for (int g = 0; g < 2; g++) {
        unsigned u0 = pack2(st[qt][2 * g][0], st[qt][2 * g][1]), u1 = pack2(st[qt][2 * g][2], st[qt][2 * g][3]);
        unsigned u2 = pack2(st[qt][2 * g + 1][0], st[qt][2 * g + 1][1]), u3 = pack2(st[qt][2 * g + 1][2], st[qt][2 * g + 1][3]);
        uint4 uu = make_uint4(u0, u1, u2, u3);
        pf[qt][g] = __builtin_bit_cast(bf16x8, uu);
      }
    if (!late) pv_accum<NDT>(ot, pf, sV, l15, quad);
    {
      const int vnext = (vcur == 2) ? 0 : vcur + 1;
      if (kt + 1 < kt_hi) STOREKV(kcur ^ 1, vnext);
      if (kt + 2 < kt_hi) LOADKV(kt + 2);
      RAW_BARRIER();
      kcur ^= 1; vprev = vcur; vcur = vnext;
    }
  }
  if (late) pv_accum<NDT>(ot, pf, sV0 + vprev * VST, l15, quad);
  float inv[2];
#pragma unroll
  for (int qt = 0; qt < 2; qt++) {
    float l = lrun[qt];
    l = quad_allsum(l);
    inv[qt] = 1.f / l;
  }
  if (IS_A) {
#pragma unroll
    for (int qt = 0; qt < 2; qt++) {
      const size_t tok = (size_t)(b * T + q0 + wq + qt * 16 + l15);
#pragma unroll
      for (int i = 0; i < NDT; i++) {
        u16* yp = Yg + tok * 512 + h * DV + i * 16 + quad * 4;
        uint2 gz = *(const uint2*)yp;
        float g0 = bf2f((u16)(gz.x & 0xffff)), g1 = bf2f((u16)(gz.x >> 16)), g2 = bf2f((u16)(gz.y & 0xffff)), g3 = bf2f((u16)(gz.y >> 16));
        float o0 = ot[i][qt][0] * inv[qt] * siluf_(g0), o1 = ot[i][qt][1] * inv[qt] * siluf_(g1);
        float o2 = ot[i][qt][2] * inv[qt] * siluf_(g2), o3 = ot[i][qt][3] * inv[qt] * siluf_(g3);
        *(uint2*)yp = make_uint2(pack2(o0, o1), pack2(o2, o3));
      }
    }
  } else {
    const float lam_init = 0.8f - 0.6f * expf(-0.3f * (float)layer);
    const float lam = ((const float*)(WS + OFF_CNT))[32 + layer];
    float* sO2 = (float*)smem;
    __syncthreads();
    if (map == 1) {
#pragma unroll
      for (int qt = 0; qt < 2; qt++)
#pragma unroll
        for (int i = 0; i < NDT; i++)
#pragma unroll
          for (int j = 0; j < 4; j++) sO2[(wq + qt * 16 + l15) * 132 + i * 16 + quad * 4 + j] = ot[i][qt][j] * inv[qt];
    }
    __syncthreads();
    if (map == 0) {
      const float* sg = p.diff_subln + layer * 128;
#pragma unroll
      for (int qt = 0; qt < 2; qt++) {
        float ss = 0.f;
#pragma unroll
        for (int i = 0; i < NDT; i++)
#pragma unroll
          for (int j = 0; j < 4; j++) {
            float o = ot[i][qt][j] * inv[qt] - lam * sO2[(wq + qt * 16 + l15) * 132 + i * 16 + quad * 4 + j];
            ot[i][qt][j] = o; ss += o * o;
          }
        ss = quad_allsum(ss);
        const float r = rsqrtf(ss * (1.f / 128.f) + 1e-6f) * (1.f - lam_init);
        const size_t tok = (size_t)(b * T + q0 + wq + qt * 16 + l15);
#pragma unroll
        for (int i = 0; i < NDT; i++) {
          const int dv = i * 16 + quad * 4;
          u16* yp = Yg + tok * 512 + h * DV + dv;
          uint2 gz = *(const uint2*)yp;
          float g0 = bf2f((u16)(gz.x & 0xffff)), g1 = bf2f((u16)(gz.x >> 16)), g2 = bf2f((u16)(gz.y & 0xffff)), g3 = bf2f((u16)(gz.y >> 16));
          float o0 = ot[i][qt][0] * r * sg[dv + 0] * siluf_(g0), o1 = ot[i][qt][1] * r * sg[dv + 1] * siluf_(g1);
          float o2 = ot[i][qt][2] * r * sg[dv + 2] * siluf_(g2), o3 = ot[i][qt][3] * r * sg[dv + 3] * siluf_(g3);
          *(uint2*)yp = make_uint2(pack2(o0, o1), pack2(o2, o3));
        }
      }
    }
  }
}

DI void c_prepass(const Params& p, int layer, int ci, char* smem) {
  const int tid = opaque_tid(), lane = tid & 63, w = tid >> 6, l15 = lane & 15, quad = lane >> 4;
  char* const WS = opaque_ws(p.ws);
  const int BID = opaque_bid(); (void)BID;
  const int n = ci & 255, bh = ci >> 8, b = bh >> 2, h = bh & 3;
  const int t0 = n * 64;
  const size_t tok0 = (size_t)b * T + t0;
  u16* sQb = (u16*)smem;
  u16* sKb = sQb + 64 * 136;
  u16* sVbT = sKb + 64 * 136;
  u16* sKbT = sVbT + 128 * 72;
  char* r2 = (char*)(sKbT + 128 * 72);
  u16* sKdT = (u16*)r2;
  float* sM = (float*)r2;
  u16* sTb = (u16*)(sM + 64 * 68 + 64);
  float* sG = (float*)(sTb + 64 * 72);
  float* sBeta = sG + 64;
  const u16* grp = (const u16*)(WS + OFF_GRP);
  const float* bd = (const float*)(WS + OFF_BD);
  __syncthreads();
  if (w == 0) {
    const float* bdr = bd + (tok0 + lane) * 8;
    float beta = sigmoidf_(bdr[h]);
    float xa = bdr[4 + h] + p.dn_dt_bias[layer * 4 + h];
    float sp = xa > 20.f ? xa : log1pf(expf(xa));
    float g = -expf(p.dn_a_log[layer * 4 + h]) * sp;
#pragma unroll
    for (int o = 1; o < 64; o <<= 1) { float t = __shfl_up(g, o); if (lane >= o) g += t; }
    sG[lane] = g; sBeta[lane] = beta;
  }
  __syncthreads();
  const float Glast = sG[63];
  {
    const float* cw = p.dn_conv + (size_t)layer * 4 * 1536;
    u16* cQ = (u16*)(WS + OFF_CQ) + (size_t)ci * 8192;
    const int i0 = w * 8;
    const int ch = h * 128 + 2 * lane;
    float v6[8][6];
#pragma unroll
    for (int part = 0; part < 3; part++) {
      const u16* src = grp + (size_t)(8 + part) * (SZ_GRP / 2);
      unsigned xin[11];
#pragma unroll
      for (int r = 0; r < 11; r++) {
        const int tl = t0 + i0 - 3 + r;
        xin[r] = tl >= 0 ? *(const unsigned*)(src + ((size_t)b * T + tl) * 512 + ch) : 0u;
      }
      float2 wj[4];
#pragma unroll
      for (int j = 0; j < 4; j++) wj[j] = *(const float2*)(cw + j * 1536 + part * 512 + ch);
#pragma unroll
      for (int ii = 0; ii < 8; ii++) {
        float a0 = 0.f, a1 = 0.f;
#pragma unroll
        for (int j = 0; j < 4; j++) {
          a0 += wj[j].x * __uint_as_float(xin[ii + j] << 16);
          a1 += wj[j].y * __uint_as_float(xin[ii + j] & 0xffff0000u);
        }
        v6[ii][part * 2] = siluf_(a0);
        v6[ii][part * 2 + 1] = siluf_(a1);
      }
    }
#pragma unroll
    for (int ii = 0; ii < 8; ii++) {
      const int i = i0 + ii;
      float sq = wave_sum(v6[ii][0] * v6[ii][0] + v6[ii][1] * v6[ii][1]);
      float sk = wave_sum(v6[ii][2] * v6[ii][2] + v6[ii][3] * v6[ii][3]);
      const float rq = rsqrtf(sq + 1e-6f) * 0.08838834764831845f, rk = rsqrtf(sk + 1e-6f);
      const float Gi = sG[i], bi = sBeta[i];
      const float eG = __expf(Gi), eGl = __expf(Glast - Gi);
      const float q0 = v6[ii][0] * rq, q1 = v6[ii][1] * rq, k0 = v6[ii][2] * rk, k1 = v6[ii][3] * rk;
      const int dd = 2 * lane;
      *(unsigned*)(sQb + i * 136 + dd) = pack2(q0, q1);
      *(unsigned*)(sKb + i * 136 + dd) = pack2(k0, k1);
      *(unsigned*)(cQ + i * 128 + dd) = pack2(q0 * eG, q1 * eG);
      sVbT[dd * 72 + i] = f2bf(v6[ii][4] * bi);
      sVbT[(dd + 1) * 72 + i] = f2bf(v6[ii][5] * bi);
      sKbT[dd * 72 + i] = f2bf(k0 * bi * eG);
      sKbT[(dd + 1) * 72 + i] = f2bf(k1 * bi * eG);
      sKdT[dd * 72 + i] = f2bf(k0 * eGl);
      sKdT[(dd + 1) * 72 + i] = f2bf(k1 * eGl);
    }
  }
  __syncthreads();
  {
    u16* cKd = (u16*)(WS + OFF_CKD) + (size_t)ci * 8192;
#pragma unroll
    for (int i = 0; i < 2; i++) { int c = tid + NTHREADS * i; int row = c >> 3, kc = c & 7; *(uint4*)(cKd + row * 64 + kc * 8) = *(const uint4*)(sKdT + row * 72 + kc * 8); }
    if (tid < 128) ((float*)(WS + OFF_CDEC))[(size_t)ci * 128 + tid] = __expf(Glast);
  }
  f32x4 akk[2], aqk[2];
#pragma unroll
  for (int tt = 0; tt < 2; tt++) {
    const int tile = w + 8 * tt, rt = tile >> 2, ct = tile & 3;
    akk[tt] = zero4(); aqk[tt] = zero4();
#pragma unroll
    for (int ks = 0; ks < 4; ks++) {
      bf16x8 bk = ld8(sKb + (ct * 16 + l15) * 136 + ks * 32 + quad * 8);
      bf16x8 ak = ld8(sKb + (rt * 16 + l15) * 136 + ks * 32 + quad * 8);
      bf16x8 aq = ld8(sQb + (rt * 16 + l15) * 136 + ks * 32 + quad * 8);
      akk[tt] = mfma16(ak, bk, akk[tt]);
      aqk[tt] = mfma16(aq, bk, aqk[tt]);
    }
  }
  __syncthreads();
  {
    u16* cA = (u16*)(WS + OFF_CA) + (size_t)ci * 4096;
#pragma unroll
    for (int tt = 0; tt < 2; tt++) {
      const int tile = w + 8 * tt, rt = tile >> 2, ct = tile & 3;
      const int jc = ct * 16 + l15;
      const float Gj = sG[jc];
#pragma unroll
      for (int j = 0; j < 4; j++) {
        const int ir = rt * 16 + quad * 4 + j;
        const float gam = jc <= ir ? __expf(sG[ir] - Gj) : 0.f;
        sM[ir * 68 + jc] = jc < ir ? sBeta[ir] * akk[tt][j] * gam : 0.f;
        cA[ir * 64 + jc] = f2bf(aqk[tt][j] * gam);
      }
    }
  }
  __syncthreads();
  if (w == 0) {
    float tc[64];
#pragma unroll
    for (int i = 0; i < 64; i++) {
      float sp[4] = {(i == lane) ? 1.f : 0.f, 0.f, 0.f, 0.f};
#pragma unroll
      for (int j = 0; j < i; j++) sp[j & 3] -= sM[i * 68 + j] * tc[j];
      const float s = (sp[0] + sp[1]) + (sp[2] + sp[3]);
      tc[i] = s;
      sTb[i * 72 + lane] = f2bf(s);
    }
  }
  __syncthreads();
  {
    u16* cU = (u16*)(WS + OFF_CU);
    u16* cW = (u16*)(WS + OFF_CW) + (size_t)ci * 8192;
    const int ct = w;
#pragma unroll
    for (int rt = 0; rt < 4; rt++) {
      f32x4 au = zero4(), aw = zero4();
#pragma unroll
      for (int ks = 0; ks < 2; ks++) {
        bf16x8 at = ld8(sTb + (rt * 16 + l15) * 72 + ks * 32 + quad * 8);
        bf16x8 bv = ld8(sVbT + (ct * 16 + l15) * 72 + ks * 32 + quad * 8);
        bf16x8 bk = ld8(sKbT + (ct * 16 + l15) * 72 + ks * 32 + quad * 8);
        au = mfma16(at, bv, au);
        aw = mfma16(at, bk, aw);
      }
      *(uint2*)(cU + ((size_t)(b * 512 + h * 128 + ct * 16 + l15)) * T + t0 + rt * 16 + quad * 4) = make_uint2(pack2_safe(au[0], au[1]), pack2_safe(au[2], au[3]));
#pragma unroll
      for (int j = 0; j < 4; j++) {
        const int ir = rt * 16 + quad * 4 + j;
        cW[ir * 128 + ct * 16 + l15] = f2bf(aw[j]);
      }
    }
  }
}

DI void d_prepass(const Params& p, int layer, int ci, char* smem) {
  const int tid = opaque_tid(), lane = tid & 63, w = tid >> 6, l15 = lane & 15, quad = lane >> 4;
  char* const WS = opaque_ws(p.ws);
  const int BID = opaque_bid(); (void)BID;
  const int n = ci & 255, bh = ci >> 8, b = bh >> 2, h = bh & 3;
  const size_t tok0 = (size_t)b * T + n * 64;
  float* sBc = (float*)smem;
  float* sKv = sBc + 64 * 128;
  u16* sQh = (u16*)(sKv + 64 * 128);
  u16* sKh = sQh + 64 * 136;
  u16* sKdT = sKh + 64 * 136;
  float* sPart = (float*)(sKdT + 128 * 72);
  u16* grp = (u16*)(WS + OFF_GRP);
  u16* dq = grp + (size_t)12 * (SZ_GRP / 2);
  const u16* df = grp + (size_t)13 * (SZ_GRP / 2);
  __syncthreads();
  const int d = tid & 127, qtr = tid >> 7;
  float lb = 0.f;
  if (layer == 1) lb = sigmoidf_(p.hg_lb_logits[512 + h * 128 + d] - p.hg_lb_logits[h * 128 + d]);
  lb = fminf(fmaxf(lb, 0.f), 1.f);
  {
    float run = 0.f;
    for (int r = 0; r < 16; r++) {
      const int i = qtr * 16 + r;
      float fr = bf2f(df[(tok0 + i) * 512 + h * 128 + d]);
      float kk = (1.f - lb) * sigmoidf_(-fr);
      float lf = __logf(1.f - kk);
      run += lf;
      sBc[i * 128 + d] = run;
      sKv[i * 128 + d] = kk;
    }
    sPart[qtr * 128 + d] = run;
  }
  __syncthreads();
  {
    float off = 0.f;
    for (int q2 = 0; q2 < qtr; q2++) off += sPart[q2 * 128 + d];
    for (int r = 0; r < 16; r++) sBc[(qtr * 16 + r) * 128 + d] += off;
  }
  __syncthreads();
  {
    const float bl = sBc[63 * 128 + d], bm = sBc[31 * 128 + d];
    for (int r = 0; r < 16; r++) {
      const int i = qtr * 16 + r;
      const float bc = sBc[i * 128 + d], kk = sKv[i * 128 + d];
      u16* qp = dq + (tok0 + i) * 512 + h * 128 + d;
      const float q = bf2f(*qp);
      *qp = f2bf(q * __expf(bc));
      sQh[i * 136 + d] = f2bf(q * __expf(bc - bm));
      sKh[i * 136 + d] = f2bf(kk * __expf(bm - bc));
      sKdT[d * 72 + i] = f2bf(kk * __expf(bl - bc));
    }
    if (qtr == 0) ((float*)(WS + OFF_DDEC))[(size_t)ci * 128 + d] = __expf(bl);
  }
  __syncthreads();
  {
    u16* dKd = (u16*)(WS + OFF_DKD) + (size_t)ci * 8192;
#pragma unroll
    for (int i = 0; i < 2; i++) { int c = tid + NTHREADS * i; int row = c >> 3, kc = c & 7; *(uint4*)(dKd + row * 64 + kc * 8) = *(const uint4*)(sKdT + row * 72 + kc * 8); }
    u16* dA = (u16*)(WS + OFF_DA) + (size_t)ci * 4096;
#pragma unroll
    for (int tt = 0; tt < 2; tt++) {
      const int tile = w + 8 * tt, rt = tile >> 2, ct = tile & 3;
      f32x4 a = zero4();
#pragma unroll
      for (int ks = 0; ks < 4; ks++) {
        bf16x8 aq = ld8(sQh + (rt * 16 + l15) * 136 + ks * 32 + quad * 8);
        bf16x8 bk = ld8(sKh + (ct * 16 + l15) * 136 + ks * 32 + quad * 8);
        a = mfma16(aq, bk, a);
      }
      const int jc = ct * 16 + l15;
#pragma unroll
      for (int j = 0; j < 4; j++) {
        const int ir = rt * 16 + quad * 4 + j;
        dA[ir * 64 + jc] = f2bf(jc <= ir ? a[j] : 0.f);
      }
    }
  }
}

struct ScanRegs {
  bf16x8 wf[4], qf[4], af[2], kdf[2];
  float decv;
  uint2 u[2];
};

template <bool DELTA>
DI void scan_load(ScanRegs& r, const u16* U, const u16* W, const u16* Q, int ldq, const u16* KdT, const u16* A, const float* dec,
                  int rt, int cbase, int w, int l15, int quad) {
#pragma unroll
  for (int ks = 0; ks < 4; ks++) {
    if (DELTA) r.wf[ks] = ld8(W + (rt * 16 + l15) * 128 + ks * 32 + quad * 8);
    r.qf[ks] = ld8(Q + (size_t)(rt * 16 + l15) * ldq + ks * 32 + quad * 8);
  }
#pragma unroll
  for (int ks = 0; ks < 2; ks++) {
    r.af[ks] = ld8(A + (rt * 16 + l15) * 64 + ks * 32 + quad * 8);
    r.kdf[ks] = ld8(KdT + (w * 16 + l15) * 64 + ks * 32 + quad * 8);
  }
  r.decv = dec[w * 16 + l15];
#pragma unroll
  for (int c2 = 0; c2 < 2; c2++) r.u[c2] = *(const uint2*)(U + (size_t)((cbase + c2) * 16 + l15) * T + rt * 16 + quad * 4);
}

template <bool DELTA>
DI void scan_item(const Params& p, int layer, int item, char* smem) {
  const int tid = opaque_tid(), lane = tid & 63, w = tid >> 6, l15 = lane & 15, quad = lane >> 4;
  char* const WS = opaque_ws(p.ws);
  const int BID = opaque_bid(); (void)BID;
  const int bh = item >> 1, half = item & 1;
  const int b = bh >> 2, h = bh & 3;
  u16* sSt = (u16*)smem;
  u16* sVnT = sSt + 2 * 64 * 136;
  u16* grp = (u16*)(WS + OFF_GRP);
  const u16* Ubase = DELTA ? (const u16*)(WS + OFF_CU) : grp + (size_t)14 * (SZ_GRP / 2);
  u16* Obase = grp + (size_t)(DELTA ? 8 : 13) * (SZ_GRP / 2);
  const int rt = w >> 1, cbase = (w & 1) * 2;
  const int colofs = h * 128 + half * 64;
  __syncthreads();
  for (int e = tid; e < 64 * 136; e += NTHREADS) sSt[e] = 0;
  f32x4 accS[4];
#pragma unroll
  for (int i = 0; i < 4; i++) accS[i] = zero4();
  ScanRegs cur, nxt;
#define SCAN_LOAD(R, N) { \
      const size_t ci_ = (size_t)bh * 256 + (N); \
      const size_t tk_ = (size_t)b * T + (N) * 64; \
      const u16* U_ = Ubase + ((size_t)(b * 512 + colofs)) * T + (N) * 64; \
      const u16* Wp_ = (const u16*)(WS + OFF_CW) + ci_ * 8192; \
      const u16* Qp_ = DELTA ? (const u16*)(WS + OFF_CQ) + ci_ * 8192 : grp + (size_t)12 * (SZ_GRP / 2) + tk_ * 512 + h * 128; \
      const u16* Kd_ = (const u16*)(WS + (DELTA ? OFF_CKD : OFF_DKD)) + ci_ * 8192; \
      const u16* Ap_ = (const u16*)(WS + (DELTA ? OFF_CA : OFF_DA)) + ci_ * 4096; \
      const float* dc_ = (const float*)(WS + (DELTA ? OFF_CDEC : OFF_DDEC)) + ci_ * 128; \
      scan_load<DELTA>(R, U_, Wp_, Qp_, DELTA ? 128 : 512, Kd_, Ap_, dc_, rt, cbase, w, l15, quad); }
  SCAN_LOAD(cur, 0);
  __syncthreads();
  int sb = 0;
  for (int n = 0; n < 256; n++) {
    if (n + 1 < 256) SCAN_LOAD(nxt, n + 1);
    const u16* sStc = sSt + sb * 64 * 136;
    u16* sStn = sSt + (sb ^ 1) * 64 * 136;
    bf16x8 sf[2][4];
#pragma unroll
    for (int c2 = 0; c2 < 2; c2++)
#pragma unroll
      for (int ks = 0; ks < 4; ks++) sf[c2][ks] = ld8(sStc + ((cbase + c2) * 16 + l15) * 136 + ks * 32 + quad * 8);
    __builtin_amdgcn_sched_barrier(0);
#pragma unroll
    for (int c2 = 0; c2 < 2; c2++) {
      const int ct = cbase + c2;
      float vn[4];
      if (DELTA) {
        f32x4 a = zero4();
#pragma unroll
        for (int ks = 0; ks < 4; ks++) a = mfma16(cur.wf[ks], sf[c2][ks], a);
        vn[0] = __uint_as_float(cur.u[c2].x << 16) - a[0]; vn[1] = __uint_as_float(cur.u[c2].x & 0xffff0000u) - a[1];
        vn[2] = __uint_as_float(cur.u[c2].y << 16) - a[2]; vn[3] = __uint_as_float(cur.u[c2].y & 0xffff0000u) - a[3];
      } else {
        vn[0] = __uint_as_float(cur.u[c2].x << 16); vn[1] = __uint_as_float(cur.u[c2].x & 0xffff0000u);
        vn[2] = __uint_as_float(cur.u[c2].y << 16); vn[3] = __uint_as_float(cur.u[c2].y & 0xffff0000u);
      }
      *(uint2*)(sVnT + (ct * 16 + l15) * 72 + rt * 16 + quad * 4) = make_uint2(pack2(vn[0], vn[1]), pack2(vn[2], vn[3]));
    }
    RAW_BARRIER();
    {
      const size_t tok0 = (size_t)b * T + n * 64;
      bf16x8 vf2[2][2], vf3[4][2];
#pragma unroll
      for (int c2 = 0; c2 < 2; c2++)
#pragma unroll
        for (int ks = 0; ks < 2; ks++) vf2[c2][ks] = ld8(sVnT + ((cbase + c2) * 16 + l15) * 72 + ks * 32 + quad * 8);
#pragma unroll
      for (int dvt = 0; dvt < 4; dvt++)
#pragma unroll
        for (int ks = 0; ks < 2; ks++) vf3[dvt][ks] = ld8(sVnT + (dvt * 16 + l15) * 72 + ks * 32 + quad * 8);
      __builtin_amdgcn_sched_barrier(0);
#pragma unroll
      for (int c2 = 0; c2 < 2; c2++) {
        const int ct = cbase + c2;
        f32x4 a = zero4();
#pragma unroll
        for (int ks = 0; ks < 4; ks++) a = mfma16(cur.qf[ks], sf[c2][ks], a);
#pragma unroll
        for (int ks = 0; ks < 2; ks++) a = mfma16(cur.af[ks], vf2[c2][ks], a);
#pragma unroll
        for (int j = 0; j < 4; j++) Obase[(tok0 + rt * 16 + quad * 4 + j) * 512 + colofs + ct * 16 + l15] = f2bf(a[j]);
      }
#pragma unroll
      for (int dvt = 0; dvt < 4; dvt++) {
        f32x4 a = accS[dvt];
        a[0] *= cur.decv; a[1] *= cur.decv; a[2] *= cur.decv; a[3] *= cur.decv;
#pragma unroll
        for (int ks = 0; ks < 2; ks++) a = mfma16(vf3[dvt][ks], cur.kdf[ks], a);
        accS[dvt] = a;
#pragma unroll
        for (int j = 0; j < 4; j++) sStn[(dvt * 16 + quad * 4 + j) * 136 + w * 16 + l15] = f2bf(a[j]);
      }
    }
    RAW_BARRIER();
    sb ^= 1;
    if (n + 1 < 256) cur = nxt;
  }
#undef SCAN_LOAD
}

DI void scan_post(const Params& p, int layer) {
  const int tid = opaque_tid(), lane = tid & 63, w = tid >> 6;
  char* const WS = opaque_ws(p.ws);
  const int BID = opaque_bid(); (void)BID;
  u16* grp = (u16*)(WS + OFF_GRP);
  const int head = lane >> 4, sub = lane & 15;
  for (int r = BID * 8 + w; r < 2 * NT; r += gridDim.x * 8) {
    const int mixer = r >= NT ? 1 : 0;
    const size_t tok = (size_t)(r - mixer * NT);
    const u16* O = grp + (size_t)(mixer ? 13 : 8) * (SZ_GRP / 2) + tok * 512 + head * 128 + sub * 8;
    u16* Z = grp + (size_t)(mixer ? 15 : 11) * (SZ_GRP / 2) + tok * 512 + head * 128 + sub * 8;
    const float* gain = (mixer ? p.hg_norm_gain : p.dn_norm_gain) + layer * 128 + sub * 8;
    uint4 ov = *(const uint4*)O, zv = *(const uint4*)Z;
    unsigned oo[4] = {ov.x, ov.y, ov.z, ov.w}, zz[4] = {zv.x, zv.y, zv.z, zv.w};
    float of[8], zf[8];
#pragma unroll
    for (int i = 0; i < 4; i++) {
      of[2 * i] = __uint_as_float(oo[i] << 16); of[2 * i + 1] = __uint_as_float(oo[i] & 0xffff0000u);
      zf[2 * i] = __uint_as_float(zz[i] << 16); zf[2 * i + 1] = __uint_as_float(zz[i] & 0xffff0000u);
    }
    float ss = 0.f;
#pragma unroll
    for (int i = 0; i < 8; i++) ss += of[i] * of[i];
    ROW_ROR_ADD(ss, 8); ROW_ROR_ADD(ss, 4); ROW_ROR_ADD(ss, 2); ROW_ROR_ADD(ss, 1);
    const float rr = rsqrtf(ss * (1.f / 128.f) + 1e-6f);
    float y[8];
#pragma unroll
    for (int i = 0; i < 8; i++) y[i] = of[i] * rr * gain[i] * siluf_(zf[i]);
    *(uint4*)Z = make_uint4(pack2(y[0], y[1]), pack2(y[2], y[3]), pack2(y[4], y[5]), pack2(y[6], y[7]));
  }
}

DI void phase3(const Params& p, char* smem) {
  const int tid = opaque_tid(), lane = tid & 63, w = tid >> 6, wr = w >> 2, wc = w & 3, l15 = lane & 15, quad = lane >> 4;
  char* const WS = opaque_ws(p.ws);
  const int BID = opaque_bid(); (void)BID;
  const u16* xb = (const u16*)(WS + OFF_XB);
  const u16* Wt = (const u16*)(WS + OFF_WT);
  const u16* Wbrt = (const u16*)(WS + OFF_WBR);
  const u16* grp = (const u16*)(WS + OFF_GRP);
  const float* rstd = (const float*)(WS + OFF_RSTD);
  u16* mixed = (u16*)(WS + OFF_MIXED);
  int bstart = BID;
  if (gridDim.x == 256) { const int x = BID & 7, j = BID >> 3; const int m = (x & 3) * 8 + (j & 7), n = (x >> 2) * 4 + (j >> 3);
    bstart = ((m >> 4) << 7) | (n << 4) | (m & 15); }
  for (int id = bstart; id < 256 * 8; id += gridDim.x) {
    const int mg = id >> 7, rem = id & 127, nt = rem >> 4, mt = mg * 16 + (rem & 15);
    const int m0 = mt * 128, n0 = nt * 256;
    unsigned mxp[4][4][2];
#pragma unroll
    for (int m = 0; m < 4; m++)
#pragma unroll
      for (int n = 0; n < 4; n++) { mxp[m][n][0] = 0u; mxp[m][n][1] = 0u; }
    for (int bb = 0; bb < 4; bb++) {
      unsigned gp[4][4][2];
      {
        f32x4 g[4][4];
#pragma unroll
        for (int m = 0; m < 4; m++)
#pragma unroll
          for (int n = 0; n < 4; n++) g[m][n] = zero4();
        gemm_core8<true>((const u16*)(WS + OFF_XB8) + (size_t)m0 * 1024, (const u16*)(WS + OFF_WM8) + (size_t)(bb * 2048 + n0) * 1024, g, smem);
#pragma unroll
        for (int m = 0; m < 4; m++) {
          const float rs1 = rstd[m0 + wr * 64 + m * 16 + l15] * (1.f / 64.f);
          const float rs_[4] = {rs1, rs1, rs1, rs1};
#pragma unroll
          for (int n = 0; n < 4; n++) {
            gp[m][n][0] = pack2(sigmoidf_(g[m][n][0] * rs_[0]), sigmoidf_(g[m][n][1] * rs_[1]));
            gp[m][n][1] = pack2(sigmoidf_(g[m][n][2] * rs_[2]), sigmoidf_(g[m][n][3] * rs_[3]));
          }
        }
      }
      f32x4 yv[4][4];
#pragma unroll
      for (int m = 0; m < 4; m++)
#pragma unroll
        for (int n = 0; n < 4; n++) yv[m][n] = zero4();
      gemm_core<4, true>(grp + (size_t)(3 + 4 * bb) * (SZ_GRP / 2) + (size_t)m0 * 512, 512, Wbrt + (size_t)(bb * 2048 + n0) * 512, 512, 512, yv, smem);
#pragma unroll
      for (int m = 0; m < 4; m++)
#pragma unroll
        for (int n = 0; n < 4; n++) {
          const float a0 = fmaf(__uint_as_float(gp[m][n][0] << 16), yv[m][n][0], __uint_as_float(mxp[m][n][0] << 16));
          const float a1 = fmaf(__uint_as_float(gp[m][n][0] & 0xffff0000u), yv[m][n][1], __uint_as_float(mxp[m][n][0] & 0xffff0000u));
          const float a2 = fmaf(__uint_as_float(gp[m][n][1] << 16), yv[m][n][2], __uint_as_float(mxp[m][n][1] << 16));
          const float a3 = fmaf(__uint_as_float(gp[m][n][1] & 0xffff0000u), yv[m][n][3], __uint_as_float(mxp[m][n][1] & 0xffff0000u));
          mxp[m][n][0] = pack2(a0, a1);
          mxp[m][n][1] = pack2(a2, a3);
        }
    }
#pragma unroll
    for (int m = 0; m < 4; m++)
#pragma unroll
      for (int n = 0; n < 4; n++)
        *(uint2*)(mixed + (size_t)(m0 + wr * 64 + m * 16 + l15) * D + n0 + wc * 64 + n * 16 + quad * 4) =
            make_uint2(mxp[m][n][0], mxp[m][n][1]);
  }
}

DI void phase4(const Params& p, int layer, char* smem) {
  const int tid = opaque_tid(), lane = tid & 63, w = tid >> 6, wr = w >> 2, wc = w & 3, l15 = lane & 15, quad = lane >> 4;
  char* const WS = opaque_ws(p.ws);
  const int BID = opaque_bid(); (void)BID;
  const u16* mixed = (const u16*)(WS + OFF_MIXED);
  const u16* Woutt = (const u16*)(WS + OFF_WOUT);
  const float* xs = layer == 0 ? p.x : p.out;
  for (int id = BID; id < 128 * 8; id += gridDim.x) {
    const int mg = id >> 7, rem = id & 127, nt = rem >> 4, mt = mg * 16 + (rem & 15);
    const int m0 = mt * 256, n0 = nt * 256;
    f32x4 acc[8][4];
#pragma unroll
    for (int m = 0; m < 8; m++)
#pragma unroll
      for (int n = 0; n < 4; n++) acc[m][n] = zero4();
    gemm_core<8, true>(mixed + (size_t)m0 * D, D, Woutt + (size_t)n0 * D, D, D, acc, smem);
#pragma unroll
    for (int m = 0; m < 8; m++)
#pragma unroll
      for (int n = 0; n < 4; n++)
      {
        const size_t idx = (size_t)(m0 + wr * 128 + m * 16 + l15) * D + n0 + wc * 64 + n * 16 + quad * 4;
        const float4 xv = *(const float4*)(xs + idx);
        *(float4*)(p.out + idx) = make_float4(xv.x + acc[m][n][0], xv.y + acc[m][n][1], xv.z + acc[m][n][2], xv.w + acc[m][n][3]);
      }
  }
}

DI void final_norm(const Params& p) {
  const int tid = opaque_tid(), lane = tid & 63, w = tid >> 6;
  char* const WS = opaque_ws(p.ws);
  const int BID = opaque_bid(); (void)BID;
  for (int row = BID * 8 + w; row < NT; row += gridDim.x * 8) {
    float4* s4 = (float4*)(p.out + (size_t)row * D);
    const float4* g4 = (const float4*)p.final_gain;
    float4 v[8];
    float ss = 0.f;
#pragma unroll
    for (int i = 0; i < 8; i++) { v[i] = s4[lane + 64 * i]; ss += v[i].x * v[i].x + v[i].y * v[i].y + v[i].z * v[i].z + v[i].w * v[i].w; }
    ss = wave_sum(ss);
    const float r = rsqrtf(ss * (1.f / D) + 1e-6f);
#pragma unroll
    for (int i = 0; i < 8; i++) {
      float4 g = g4[lane + 64 * i];
      s4[lane + 64 * i] = make_float4(v[i].x * r * g.x, v[i].y * r * g.y, v[i].z * r * g.z, v[i].w * r * g.w);
    }
  }
}

#ifndef PH
#define PH 1023
#endif
#ifndef PROBE_MASK
#define PROBE_MASK 0
#endif
#ifndef PROBE_BLOCK
#define PROBE_BLOCK 0
#endif
#ifndef EN_A
#define EN_A 1
#endif
#ifndef EN_B
#define EN_B 1
#endif
#ifndef EN_C
#define EN_C 1
#endif
#ifndef EN_D
#define EN_D 1
#endif

__global__ void __launch_bounds__(NTHREADS) mega(Params p) {
  extern __shared__ __attribute__((aligned(16))) char smem[];
  cg::grid_group grid = cg::this_grid();
  int* cnt = (int*)(p.ws + OFF_CNT);
  long long tacc = 0, tq = 0;
#define TB(bit) if (PROBE_MASK & (bit)) tq = wall_clock64();
#define TE(bit) if (PROBE_MASK & (bit)) tacc += wall_clock64() - tq;
  for (int layer = 0; layer < 2; layer++) {
    TB(1)
#if PH&1
    phase0(p, layer, smem);
#endif
    grid.sync();
    TE(1)
    TB(2)
#if PH&2
    phase1(p, smem);
#endif
    grid.sync();
    TE(2)
    TB(4)
    for (;;) {
      int it = next_item(cnt + layer * 2);
      if (it >= 2048 + 2048 + 1024) break;
#if PH&4
      TB(128)
      if (it < 2048) c_prepass(p, layer, it, smem);
      TE(128)
#endif
#if PH&8
      TB(256)
      if (it >= 2048 && it < 4096) d_prepass(p, layer, it - 2048, smem);
      TE(256)
#endif
#if PH&16
      if (it >= 4096) attn_item<64, 1, true>(p, layer, it - 4096, smem);
#endif
    }
    grid.sync();
    TE(4)
    TB(8)
#if PH&32
    TB(64)
    const int sbid = opaque_bid();
    if (sbid < 16) scan_item<true>(p, layer, sbid, smem);
    TE(64)
#endif
#if PH&64
    TB(512)
    if (sbid >= 16 && sbid < 32) scan_item<false>(p, layer, sbid - 16, smem);
    TE(512)
#endif
    for (;;) {
      int it = next_item(cnt + layer * 2 + 1);
      if (it >= 1024) break;
#if PH&128
      attn_item<128, 2, false>(p, layer, it, smem);
#endif
    }
    grid.sync();
    TE(8)
    TB(16)
    scan_post(p, layer);
    grid.sync();
#if PH&256
    phase3(p, smem);
#endif
    grid.sync();
    TE(16)
    TB(32)
#if PH&512
    phase4(p, layer, smem);
#endif
    grid.sync();
    TE(32)
  }
  final_norm(p);
  if (PROBE_MASK && blockIdx.x == PROBE_BLOCK) { long long tend = wall_clock64() + tacc; while (wall_clock64() < tend) __builtin_amdgcn_s_sleep(20); }
}

extern "C" void kernel_launch(void* const* d_in, const int* in_sizes, int n_in, void* d_out, int out_size, void* d_ws,
                              size_t ws_size, hipStream_t stream) {
  static int grid_blocks = 0;
  if (!grid_blocks) {
    int dev = 0, cus = 0, per_cu = 0;
    hipGetDevice(&dev);
    hipDeviceGetAttribute(&cus, hipDeviceAttributeMultiprocessorCount, dev);
    hipFuncSetAttribute((const void*)mega, hipFuncAttributeMaxDynamicSharedMemorySize, LDS_BYTES);
    hipOccupancyMaxActiveBlocksPerMultiprocessor(&per_cu, (const void*)mega, NTHREADS, LDS_BYTES);
    if (per_cu < 1) per_cu = 1;
    grid_blocks = cus * per_cu;
    if (ws_size < OFF_END) fprintf(stderr, "kernel_launch: workspace too small: %zu < %zu\n", ws_size, (size_t)OFF_END);
  }
  Params p{};
  p.x = (const float*)d_in[0]; p.norm_gain = (const float*)d_in[1]; p.w_in = (const float*)d_in[2];
  p.rel_bias = (const float*)d_in[3]; p.diff_lambda = (const float*)d_in[4]; p.diff_subln = (const float*)d_in[5];
  p.dn_conv = (const float*)d_in[6]; p.dn_a_log = (const float*)d_in[7]; p.dn_dt_bias = (const float*)d_in[8];
  p.dn_norm_gain = (const float*)d_in[9]; p.hg_lb_logits = (const float*)d_in[10]; p.hg_norm_gain = (const float*)d_in[11];
  p.w_branch = (const float*)d_in[12]; p.w_out = (const float*)d_in[13]; p.final_gain = (const float*)d_in[14];
  p.out = (float*)d_out; p.ws = (char*)d_ws;
  void* args[] = {&p};
  hipError_t e = hipLaunchCooperativeKernel((void*)mega, dim3(grid_blocks), dim3(NTHREADS), args, LDS_BYTES, stream);
  if (e != hipSuccess) fprintf(stderr, "cooperative launch failed: %s (grid %d)\n", hipGetErrorString(e), grid_blocks);
}
```

```cpp
#include <hip/hip_runtime.h>
#include <hip/hip_cooperative_groups.h>
#include <cstdio>
#include <cmath>
namespace cg = cooperative_groups;

#define DI __device__ __forceinline__
typedef unsigned short u16;
using bf16x8 = __attribute__((ext_vector_type(8))) short;
using bf16x4 = __attribute__((ext_vector_type(4))) short;
using f32x4  = __attribute__((ext_vector_type(4))) float;

constexpr int D = 2048, NB = 2, T = 16384, NT = NB * T;
constexpr int NIN = 16392;
constexpr int NP1 = 8448;
constexpr int NW = NP1 + 8192;
constexpr int NTHREADS = 512;
constexpr int LDS_BYTES = 131072;
#define NEG_INF (-INFINITY)

constexpr size_t SZ_WT = (size_t)NW * 2048 * 2;
constexpr size_t SZ_WBR = (size_t)4 * 2048 * 512 * 2;
constexpr size_t SZ_WOUT = (size_t)2048 * 2048 * 2;
constexpr size_t SZ_XB = (size_t)NT * 2048 * 2;
constexpr size_t SZ_GRP = (size_t)NT * 512 * 2;
constexpr size_t SZ_CA = (size_t)2048 * 4096 * 2;
constexpr size_t SZ_DEC = (size_t)2048 * 128 * 4;
constexpr size_t OFF_WT = 0;
constexpr size_t OFF_WBR = OFF_WT + SZ_WT;
constexpr size_t OFF_WOUT = OFF_WBR + SZ_WBR;
constexpr size_t OFF_XB = OFF_WOUT + SZ_WOUT;
constexpr size_t OFF_RSTD = OFF_XB + SZ_XB;
constexpr size_t OFF_GRP = OFF_RSTD + (size_t)NT * 4;
constexpr size_t OFF_BD = OFF_GRP + 16 * SZ_GRP;
constexpr size_t OFF_CU = OFF_BD + (size_t)NT * 8 * 4;
constexpr size_t OFF_CW = OFF_CU + SZ_GRP;
constexpr size_t OFF_CQ = OFF_CW + SZ_GRP;
constexpr size_t OFF_CKD = OFF_CQ + SZ_GRP;
constexpr size_t OFF_CA = OFF_CKD + SZ_GRP;
constexpr size_t OFF_CDEC = OFF_CA + SZ_CA;
constexpr size_t OFF_DKD = OFF_CDEC + SZ_DEC;
constexpr size_t OFF_DA = OFF_DKD + SZ_GRP;
constexpr size_t OFF_DDEC = OFF_DA + SZ_CA;
constexpr size_t OFF_CNT = OFF_DDEC + SZ_DEC;
constexpr size_t OFF_XB8 = OFF_CNT + 256;
constexpr size_t OFF_END = OFF_XB8 + (size_t)NT * 2048;
constexpr size_t OFF_WM8 = OFF_WT + (size_t)NP1 * 2048 * 2;
constexpr size_t OFF_MIXED = OFF_CU;

struct Params {
  const float *x, *norm_gain, *w_in, *rel_bias, *diff_lambda, *diff_subln, *dn_conv, *dn_a_log,
      *dn_dt_bias, *dn_norm_gain, *hg_lb_logits, *hg_norm_gain, *w_branch, *w_out, *final_gain;
  float* out;
  char* ws;
};

DI float bf2f(u16 b) { return __uint_as_float(((unsigned)b) << 16); }
DI u16 f2bf(float x) {
  unsigned u = __float_as_uint(x);
  u += 0x7fffu + ((u >> 16) & 1u);
  return (u16)(u >> 16);
}
DI unsigned pack2(float a, float b) { unsigned r; asm("s_nop 0\n\tv_cvt_pk_bf16_f32 %0, %1, %2" : "=v"(r) : "v"(a), "v"(b)); return r; }
DI unsigned pack2_nop(float a, float b) { unsigned r; asm("s_nop 1\n\tv_cvt_pk_bf16_f32 %0, %1, %2\n\ts_nop 1" : "=v"(r) : "v"(a), "v"(b)); return r; }
DI unsigned pack2_safe(float a, float b) { return (unsigned)f2bf(a) | ((unsigned)f2bf(b) << 16); }
using i32x8 = __attribute__((ext_vector_type(8))) int;
DI unsigned pk_fp8x4(float a, float b, float c, float d) { int r = __builtin_amdgcn_cvt_pk_fp8_f32(a, b, 0, false); r = __builtin_amdgcn_cvt_pk_fp8_f32(c, d, r, true); return (unsigned)r; }
DI float quad_allmax(float x) {
  unsigned u = __float_as_uint(x);
  auto r = __builtin_amdgcn_permlane16_swap(u, u, false, false);
  float m = fmaxf(__uint_as_float(r[0]), __uint_as_float(r[1]));
  u = __float_as_uint(m);
  auto r2 = __builtin_amdgcn_permlane32_swap(u, u, false, false);
  return fmaxf(__uint_as_float(r2[0]), __uint_as_float(r2[1]));
}
DI float quad_allsum(float x) {
  unsigned u = __float_as_uint(x);
  auto r = __builtin_amdgcn_permlane16_swap(u, u, false, false);
  float m = __uint_as_float(r[0]) + __uint_as_float(r[1]);
  u = __float_as_uint(m);
  auto r2 = __builtin_amdgcn_permlane32_swap(u, u, false, false);
  return __uint_as_float(r2[0]) + __uint_as_float(r2[1]);
}
#define ROW_ROR_ADD(v_, n_) v_ += __int_as_float(__builtin_amdgcn_update_dpp(0, __float_as_int(v_), 0x120 + (n_), 0xf, 0xf, false))
DI float wave_sum(float v) {
  ROW_ROR_ADD(v, 8); ROW_ROR_ADD(v, 4); ROW_ROR_ADD(v, 2); ROW_ROR_ADD(v, 1);
  return quad_allsum(v);
}
DI float sigmoidf_(float x) { return __builtin_amdgcn_rcpf(1.f + __expf(-x)); }
DI float siluf_(float x) { return x * __builtin_amdgcn_rcpf(1.f + __expf(-x)); }
DI f32x4 mfma16(bf16x8 a, bf16x8 b, f32x4 c) { return __builtin_amdgcn_mfma_f32_16x16x32_bf16(a, b, c, 0, 0, 0); }
DI bf16x8 ld8(const u16* p) { return *reinterpret_cast<const bf16x8*>(p); }
DI bf16x4 ld4(const u16* p) { return *reinterpret_cast<const bf16x4*>(p); }
DI f32x4 zero4() { f32x4 z = {0.f, 0.f, 0.f, 0.f}; return z; }

typedef __attribute__((address_space(1))) char gchar;
DI char* opaque_ws(char* q) { unsigned long v = (unsigned long)q; asm volatile("" : "+s"(v)); return (char*)(gchar*)v; }
DI int opaque_bid() { int t = blockIdx.x; asm volatile("" : "+s"(t)); return t; }
DI int opaque_tid() { int t = threadIdx.x; asm volatile("" : "+v"(t)); return t; }
__shared__ int s_item;

DI int next_item(int* cnt) {
  __syncthreads();
  if (threadIdx.x == 0) s_item = atomicAdd(cnt, 1);
  __syncthreads();
  return s_item;
}

template <int WM, int WN>
DI void gemm_tile(const u16* __restrict__ A, int lda, const u16* __restrict__ Bt, int ldb, int K,
                  f32x4 (&acc)[WM][WN], char* smem) {
  constexpr int BM = 64 * WM, BN = 32 * WN;
  constexpr int NA = BM * 8 / NTHREADS, NBC = BN * 8 / NTHREADS;
  constexpr int LP = 72;
  const int tid = opaque_tid(), lane = tid & 63, w = tid >> 6, wr = w >> 1, wc = w & 1;
  const int l15 = lane & 15, quad = lane >> 4;
  u16* sA = (u16*)smem;
  u16* sB = sA + 2 * BM * LP;
  uint4 ra0, ra1, ra2, ra3, rb0, rb1;
  ra2 = make_uint4(0, 0, 0, 0); ra3 = ra2;
  static_assert(NBC == 2 && (NA == 2 || NA == 4), "tile config");
  const int nk = K / 64;
#define G_LD(dst_, P_, ld_, i_, k0_) { int c = tid + NTHREADS * (i_); dst_ = *(const uint4*)(P_ + (size_t)(c >> 3) * ld_ + (k0_) + (c & 7) * 8); }
#define G_ST(src_, S_, i_) { int c = tid + NTHREADS * (i_); *(uint4*)(S_ + (c >> 3) * LP + (c & 7) * 8) = src_; }
#define G_LOADALL(k0_) { G_LD(ra0, A, lda, 0, k0_); G_LD(ra1, A, lda, 1, k0_); if (NA > 2) { G_LD(ra2, A, lda, 2, k0_); G_LD(ra3, A, lda, 3, k0_); } \
                         G_LD(rb0, Bt, ldb, 0, k0_); G_LD(rb1, Bt, ldb, 1, k0_); }
#define G_STOREALL(SA_, SB_) { G_ST(ra0, SA_, 0); G_ST(ra1, SA_, 1); if (NA > 2) { G_ST(ra2, SA_, 2); G_ST(ra3, SA_, 3); } G_ST(rb0, SB_, 0); G_ST(rb1, SB_, 1); }
  __syncthreads();
  G_LOADALL(0);
  G_STOREALL(sA, sB);
  __syncthreads();
  int buf = 0;
  for (int kt = 0; kt < nk; kt++) {
    const bool more = (kt + 1 < nk);
    if (more) { const int k0 = (kt + 1) * 64; G_LOADALL(k0); }
    const u16* cA = sA + buf * BM * LP + (wr * WM * 16 + l15) * LP + quad * 8;
    const u16* cB = sB + buf * BN * LP + (wc * WN * 16 + l15) * LP + quad * 8;
#pragma unroll
    for (int ks = 0; ks < 2; ks++) {
      bf16x8 af[WM], bfr[WN];
#pragma unroll
      for (int m = 0; m < WM; m++) af[m] = ld8(cA + m * 16 * LP + ks * 32);
#pragma unroll
      for (int n = 0; n < WN; n++) bfr[n] = ld8(cB + n * 16 * LP + ks * 32);
#pragma unroll
      for (int m = 0; m < WM; m++)
#pragma unroll
        for (int n = 0; n < WN; n++) acc[m][n] = mfma16(af[m], bfr[n], acc[m][n]);
    }
    if (more) {
      u16* dA = sA + (buf ^ 1) * BM * LP;
      u16* dB = sB + (buf ^ 1) * BN * LP;
      G_STOREALL(dA, dB);
    }
    __syncthreads();
    buf ^= 1;
  }
#undef G_LD
#undef G_ST
#undef G_LOADALL
#undef G_STOREALL
}

DI int lds_byte2(int r, int c) {
  int st = (r >> 4) * 2 + (c >> 5), ob = (r & 15) * 64 + (c & 31) * 2;
  return st * 1024 + (ob ^ (((ob >> 9) & 1) << 5));
}
DI void stage_rc2(int b, int& R, int& C) {
  int st = b >> 10, sb = b & 1023, swz = sb ^ (((sb >> 9) & 1) << 5);
  R = (st >> 1) * 16 + swz / 64;
  C = (st & 1) * 32 + (swz % 64) / 2;
}
#define WAIT_V0() asm volatile("s_waitcnt vmcnt(0)" ::: "memory")
#define RAW_BARRIER() do { asm volatile("s_waitcnt lgkmcnt(0)" ::: "memory"); __builtin_amdgcn_s_barrier(); asm volatile("" ::: "memory"); } while (0)

template <int MT, bool SWAP>
DI void gemm_core(const u16* __restrict__ Ab, int lda, const u16* __restrict__ Bb, int ldb, int K,
                  f32x4 (&acc)[MT][4], char* smem) {
  constexpr int TILE_A = MT * 32 * 64 * 2, TILE_B = 256 * 64 * 2, STAGE_B = TILE_A + TILE_B;
  constexpr int GLA = TILE_A / 8192, GLB = 4;
  static_assert(2 * STAGE_B <= LDS_BYTES, "LDS");
  const int tid = opaque_tid(), wid = tid >> 6, lane = tid & 63, wr = wid >> 2, wc = wid & 3, fr = lane & 15, fq = lane >> 4;
  int offA[GLA], offB[GLB];
#pragma unroll
  for (int i = 0; i < GLA; ++i) { int R, C; stage_rc2(wid * 1024 + i * 8192 + lane * 16, R, C); offA[i] = R * lda + C; }
#pragma unroll
  for (int i = 0; i < GLB; ++i) { int R, C; stage_rc2(wid * 1024 + i * 8192 + lane * 16, R, C); offB[i] = R * ldb + C; }
#define G_STAGE(buf, kt) do { \
    _Pragma("unroll") for (int i = 0; i < GLA; ++i) \
      __builtin_amdgcn_global_load_lds((const unsigned*)(Ab + offA[i] + (kt) * 64), (__attribute__((address_space(3))) unsigned*)(smem + (buf) * STAGE_B + wid * 1024 + i * 8192), 16, 0, 0); \
    _Pragma("unroll") for (int i = 0; i < GLB; ++i) \
      __builtin_amdgcn_global_load_lds((const unsigned*)(Bb + offB[i] + (kt) * 64), (__attribute__((address_space(3))) unsigned*)(smem + (buf) * STAGE_B + TILE_A + wid * 1024 + i * 8192), 16, 0, 0); \
  } while (0)
  const int nt = K / 64;
  __syncthreads();
  G_STAGE(0, 0);
  WAIT_V0();
  __syncthreads();
  for (int t = 0; t < nt; ++t) {
    const int cur = t & 1;
    if (t + 1 < nt) G_STAGE(cur ^ 1, t + 1);
    const char* sa = smem + cur * STAGE_B;
    const char* sb = sa + TILE_A;
#pragma unroll
    for (int ks = 0; ks < 2; ++ks) {
      bf16x8 At[MT], Bf[4];
#pragma unroll
      for (int m = 0; m < MT; ++m) At[m] = *(const bf16x8*)(sa + lds_byte2(wr * (MT * 16) + m * 16 + fr, ks * 32 + fq * 8));
#pragma unroll
      for (int n = 0; n < 4; ++n) Bf[n] = *(const bf16x8*)(sb + lds_byte2(wc * 64 + n * 16 + fr, ks * 32 + fq * 8));
      __builtin_amdgcn_s_setprio(1);
#pragma unroll
      for (int m = 0; m < MT; ++m)
#pragma unroll
        for (int n = 0; n < 4; ++n) acc[m][n] = SWAP ? mfma16(Bf[n], At[m], acc[m][n]) : mfma16(At[m], Bf[n], acc[m][n]);
      __builtin_amdgcn_s_setprio(0);
      __builtin_amdgcn_sched_barrier(0);
    }
    WAIT_V0();
    __syncthreads();
  }
#undef G_STAGE
}


template <bool SWAP>
DI void gemm_core8(const u16* __restrict__ Ab, const u16* __restrict__ Bb, f32x4 (&acc)[4][4], char* smem) {
  constexpr int MT = 4, lda = 1024, ldb = 1024;
  constexpr int TILE_A = MT * 32 * 64 * 2, TILE_B = 256 * 64 * 2, STAGE_B = TILE_A + TILE_B;
  constexpr int GLA = TILE_A / 8192, GLB = 4;
  const int tid = opaque_tid(), wid = tid >> 6, lane = tid & 63, wr = wid >> 2, wc = wid & 3, fr = lane & 15, fq = lane >> 4;
  int offA[GLA], offB[GLB];
#pragma unroll
  for (int i = 0; i < GLA; ++i) { int R, C; stage_rc2(wid * 1024 + i * 8192 + lane * 16, R, C); offA[i] = R * lda + C; }
#pragma unroll
  for (int i = 0; i < GLB; ++i) { int R, C; stage_rc2(wid * 1024 + i * 8192 + lane * 16, R, C); offB[i] = R * ldb + C; }
#define G_STAGE(buf, kt) do { \
    _Pragma("unroll") for (int i = 0; i < GLA; ++i) \
      __builtin_amdgcn_global_load_lds((const unsigned*)(Ab + offA[i] + (kt) * 64), (__attribute__((address_space(3))) unsigned*)(smem + (buf) * STAGE_B + wid * 1024 + i * 8192), 16, 0, 0); \
    _Pragma("unroll") for (int i = 0; i < GLB; ++i) \
      __builtin_amdgcn_global_load_lds((const unsigned*)(Bb + offB[i] + (kt) * 64), (__attribute__((address_space(3))) unsigned*)(smem + (buf) * STAGE_B + TILE_A + wid * 1024 + i * 8192), 16, 0, 0); \
  } while (0)
  constexpr int nt = 2048 / 128;
  __syncthreads();
  G_STAGE(0, 0);
  WAIT_V0();
  __syncthreads();
  for (int t = 0; t < nt; ++t) {
    const int cur = t & 1;
    if (t + 1 < nt) G_STAGE(cur ^ 1, t + 1);
    const char* sa = smem + cur * STAGE_B;
    const char* sb = sa + TILE_A;
    i32x8 At[MT];
#pragma unroll
    for (int m = 0; m < MT; ++m) {
      const uint4 lo = *(const uint4*)(sa + lds_byte2(wr * (MT * 16) + m * 16 + fr, fq * 16));
      const uint4 hi = *(const uint4*)(sa + lds_byte2(wr * (MT * 16) + m * 16 + fr, fq * 16 + 8));
      i32x8 t8 = {(int)lo.x, (int)lo.y, (int)lo.z, (int)lo.w, (int)hi.x, (int)hi.y, (int)hi.z, (int)hi.w};
      At[m] = t8;
    }
    i32x8 Bf[4];
#pragma unroll
    for (int n = 0; n < 4; ++n) {
      const uint4 lo = *(const uint4*)(sb + lds_byte2(wc * 64 + n * 16 + fr, fq * 16));
      const uint4 hi = *(const uint4*)(sb + lds_byte2(wc * 64 + n * 16 + fr, fq * 16 + 8));
      const i32x8 t8 = {(int)lo.x, (int)lo.y, (int)lo.z, (int)lo.w, (int)hi.x, (int)hi.y, (int)hi.z, (int)hi.w};
      Bf[n] = t8;
    }
    __builtin_amdgcn_sched_barrier(0);
    __builtin_amdgcn_s_setprio(1);
#pragma unroll
    for (int n = 0; n < 4; ++n)
#pragma unroll
      for (int m = 0; m < MT; ++m)
        acc[m][n] = SWAP ? __builtin_amdgcn_mfma_scale_f32_16x16x128_f8f6f4(Bf[n], At[m], acc[m][n], 0, 0, 0, 0x7F7F7F7F, 0, 0x7F7F7F7F)
                         : __builtin_amdgcn_mfma_scale_f32_16x16x128_f8f6f4(At[m], Bf[n], acc[m][n], 0, 0, 0, 0x7F7F7F7F, 0, 0x7F7F7F7F);
    __builtin_amdgcn_s_setprio(0);
    __builtin_amdgcn_sched_barrier(0);
    WAIT_V0();
    __syncthreads();
  }
#undef G_STAGE
}

DI void phase0(const Params& p, int layer, char* smem) {
  const int tid = opaque_tid(), lane = tid & 63, w = tid >> 6;
  char* const WS = opaque_ws(p.ws);
  const int BID = opaque_bid(); (void)BID;
  if (layer == 0 && BID == 0 && tid < 16) ((int*)(WS + OFF_CNT))[tid] = 0;
  if (BID == 0 && w == 0) {
    const float* dl = p.diff_lambda + layer * 256;
    const float s1 = wave_sum(dl[lane] * dl[64 + lane]), s2 = wave_sum(dl[128 + lane] * dl[192 + lane]);
    if (lane == 0) ((float*)(WS + OFF_CNT))[32 + layer] = expf(s1) - expf(s2) + (0.8f - 0.6f * expf(-0.3f * (float)layer));
  }
  const float* src = layer == 0 ? p.x : p.out;
  u16* xb = (u16*)(WS + OFF_XB);
  float* rstd = (float*)(WS + OFF_RSTD);
  for (int row = BID * 8 + w; row < NT; row += gridDim.x * 8) {
    const float4* s4 = (const float4*)(src + (size_t)row * D);
    float4 v[8];
    float ss = 0.f;
#pragma unroll
    for (int i = 0; i < 8; i++) { v[i] = s4[lane + 64 * i]; ss += v[i].x * v[i].x + v[i].y * v[i].y + v[i].z * v[i].z + v[i].w * v[i].w; }
    ss = wave_sum(ss);
    float r = rsqrtf(ss * (1.f / D) + 1e-6f);
    if (lane == 0) rstd[row] = r;
    uint2* d2 = (uint2*)(xb + (size_t)row * D);
#pragma unroll
    for (int i = 0; i < 8; i++) d2[lane + 64 * i] = make_uint2(pack2(v[i].x, v[i].y), pack2(v[i].z, v[i].w));
    unsigned* d8 = (unsigned*)(WS + OFF_XB8 + (size_t)row * D);
#pragma unroll
    for (int i = 0; i < 8; i++) d8[lane + 64 * i] = pk_fp8x4(v[i].x, v[i].y, v[i].z, v[i].w);
  }
  float* sT = (float*)smem;
  u16* Wt = (u16*)(WS + OFF_WT);
  u16* Wbrt = (u16*)(WS + OFF_WBR);
  u16* Woutt = (u16*)(WS + OFF_WOUT);
  constexpr int NT_IN = 32 * (NW / 256);
  for (int tile = BID; tile < NT_IN + 512; tile += gridDim.x) {
    const float* s; int ld; u16* dst; int K; int kt, nt; const float* gain = nullptr; int mode;
    if (tile < NT_IN) { kt = tile & 31; nt = tile >> 5; s = p.w_in + (size_t)layer * D * NIN; ld = NIN; dst = Wt; K = 2048; mode = 0; gain = p.norm_gain + layer * D; }
    else if (tile < NT_IN + 256) { int t2 = tile - NT_IN; int bb = t2 >> 6; int r = t2 & 63; kt = r & 7; nt = r >> 3;
      s = p.w_branch + ((size_t)(layer * 4 + bb)) * 512 * 2048; ld = 2048; dst = Wbrt + (size_t)bb * 2048 * 512; K = 512; mode = 1; }
    else { int t2 = tile - NT_IN - 256; kt = t2 & 31; nt = t2 >> 5; s = p.w_out + (size_t)layer * D * D; ld = 2048; dst = Woutt; K = 2048; mode = 1; }
    const int k0 = kt * 64, n0 = nt * 256;
    __syncthreads();
    {
      const int c4 = (tid & 63) * 4;
      const int np = n0 + c4;
      int oc; bool valid = true;
      if (mode == 0) {
        if (np < 6144) oc = np; else if (np < 8192) oc = np + 8; else if (np < 8200) oc = np - 2048;
        else if (np < 8448) { oc = 0; valid = false; } else oc = np - 248;
      } else oc = np;
#pragma unroll
      for (int i = 0; i < 8; i++) {
        const int r = (tid >> 6) + 8 * i;
        float4 v = valid ? *(const float4*)(s + (size_t)(k0 + r) * ld + oc) : make_float4(0.f, 0.f, 0.f, 0.f);
        if (gain) { const float gg = gain[k0 + r]; v.x *= gg; v.y *= gg; v.z *= gg; v.w *= gg; }
        float* dstl = sT + r * 257 + c4;
        dstl[0] = v.x; dstl[1] = v.y; dstl[2] = v.z; dstl[3] = v.w;
      }
    }
    __syncthreads();
    if (mode == 0 && n0 >= NP1) {
      const int nn = tid >> 1, kh = (tid & 1) * 32;
      unsigned char* d8 = (unsigned char*)(WS + OFF_WM8) + (size_t)(n0 - NP1 + nn) * 2048 + k0 + kh;
#pragma unroll
      for (int q4 = 0; q4 < 2; q4++) {
        unsigned u[4];
#pragma unroll
        for (int e = 0; e < 4; e++) {
          const int kb = kh + q4 * 16 + e * 4;
          u[e] = pk_fp8x4(sT[kb * 257 + nn] * 64.f, sT[(kb + 1) * 257 + nn] * 64.f, sT[(kb + 2) * 257 + nn] * 64.f, sT[(kb + 3) * 257 + nn] * 64.f);
        }
        *(uint4*)(d8 + q4 * 16) = make_uint4(u[0], u[1], u[2], u[3]);
      }
    } else {
      const int nn = tid >> 1, kh = (tid & 1) * 32;
      u16* drow = dst + (size_t)(n0 + nn) * K + k0 + kh;
#pragma unroll
      for (int q4 = 0; q4 < 4; q4++) {
        unsigned u[4];
#pragma unroll
        for (int e = 0; e < 4; e++) u[e] = pack2(sT[(kh + q4 * 8 + 2 * e) * 257 + nn], sT[(kh + q4 * 8 + 2 * e + 1) * 257 + nn]);
        *(uint4*)(drow + q4 * 8) = make_uint4(u[0], u[1], u[2], u[3]);
      }
    }
  }
}

DI void phase1(const Params& p, char* smem) {
  const int tid = opaque_tid(), lane = tid & 63, w = tid >> 6, wr = w >> 2, wc = w & 3, l15 = lane & 15, quad = lane >> 4;
  char* const WS = opaque_ws(p.ws);
  const int BID = opaque_bid(); (void)BID;
  const u16* xb = (const u16*)(WS + OFF_XB);
  const u16* Wt = (const u16*)(WS + OFF_WT);
  const float* rstd = (const float*)(WS + OFF_RSTD);
  u16* grp = (u16*)(WS + OFF_GRP);
  float* bd = (float*)(WS + OFF_BD);
  constexpr int NTN = NP1 / 256;
  int bstart = BID;
  if (gridDim.x == 256) { const int x = BID & 7, j = BID >> 3; bstart = (((x >> 2) * 8 + (j >> 2)) << 4) + (x & 3) * 4 + (j & 3); }
  for (int id = bstart; id < 128 * NTN; id += gridDim.x) {
    int mg = id / (NTN * 16), rem = id % (NTN * 16);
    int nt = rem >> 4, mt = mg * 16 + (rem & 15);
    int m0 = mt * 256, n0 = nt * 256;
    f32x4 acc[8][4];
#pragma unroll
    for (int m = 0; m < 8; m++)
#pragma unroll
      for (int n = 0; n < 4; n++) acc[m][n] = zero4();
    const int g = n0 >> 9;
    if (g == 2 || g == 6 || g == 14) {
      gemm_core<8, false>(xb + (size_t)m0 * D, D, Wt + (size_t)n0 * D, D, D, acc, smem);
#pragma unroll
      for (int m = 0; m < 8; m++) {
        const int rbase = m0 + wr * 128 + m * 16 + quad * 4;
        const float4 rv = *(const float4*)(rstd + rbase);
        const int b = rbase / T, tl = rbase % T;
#pragma unroll
        for (int n = 0; n < 4; n++) {
          const int col = n0 + wc * 64 + n * 16 + l15;
          u16* dst = grp + (size_t)g * (SZ_GRP / 2) + ((size_t)(b * 512 + (col & 511))) * T + tl;
          *(uint2*)dst = make_uint2(pack2(acc[m][n][0] * rv.x, acc[m][n][1] * rv.y), pack2(acc[m][n][2] * rv.z, acc[m][n][3] * rv.w));
        }
      }
    } else {
      gemm_core<8, true>(xb + (size_t)m0 * D, D, Wt + (size_t)n0 * D, D, D, acc, smem);
#pragma unroll
      for (int m = 0; m < 8; m++) {
        const int row = m0 + wr * 128 + m * 16 + l15;
        const float rs = rstd[row];
#pragma unroll
        for (int n = 0; n < 4; n++) {
          const int col4 = n0 + wc * 64 + n * 16 + quad * 4;
          if (g == 16) {
            if (col4 - 8192 < 8) *(float4*)(bd + (size_t)row * 8 + (col4 - 8192)) = make_float4(acc[m][n][0] * rs, acc[m][n][1] * rs, acc[m][n][2] * rs, acc[m][n][3] * rs);
          } else {
            u16* dst = grp + (size_t)g * (SZ_GRP / 2) + (size_t)row * 512 + (col4 & 511);
            *(uint2*)dst = make_uint2(pack2(acc[m][n][0] * rs, acc[m][n][1] * rs), pack2(acc[m][n][2] * rs, acc[m][n][3] * rs));
          }
        }
      }
    }
  }
}

DI int t5_bucket(int n) {
  if (n < 16) return n;
  float nf = (float)n;
  int large = 16 + (int)(logf(nf / 16.f) / 4.852030263919617f * 16.f);
  return large < 31 ? large : 31;
}


template <int NDT>
DI void pv_accum(f32x4 (&ot)[NDT][2], const bf16x8 (&pf)[2][2], const u16* sV, int l15, int quad) {
  constexpr int LP = 72;
#pragma unroll
  for (int g = 0; g < 2; g++) {
    bf16x8 vf[NDT];
#pragma unroll
    for (int i = 0; i < NDT; i++) {
      bf16x4 vlo = ld4(sV + (i * 16 + l15) * LP + g * 32 + quad * 4);
      bf16x4 vhi = ld4(sV + (i * 16 + l15) * LP + g * 32 + 16 + quad * 4);
      vf[i] = __builtin_shufflevector(vlo, vhi, 0, 1, 2, 3, 4, 5, 6, 7);
    }
    __builtin_amdgcn_sched_barrier(0);
#pragma unroll
    for (int i = 0; i < NDT; i++)
#pragma unroll
      for (int qt = 0; qt < 2; qt++) ot[i][qt] = mfma16(vf[i], pf[qt][g], ot[i][qt]);
    __builtin_amdgcn_sched_barrier(0);
  }
}
template <int DV, int NMAP, bool IS_A>
DI void attn_item(const Params& p, int layer, int item, char* smem) {
  constexpr int QB = NMAP == 1 ? 256 : 128;
  constexpr int NH = IS_A ? 8 : 4;
  constexpr int HW = 512 / NH;
  constexpr int NDT = DV / 16;
  constexpr int LIM = IS_A ? 2049 : 2048;
  constexpr int LP = 72;
  constexpr int GQ = IS_A ? 0 : 4;
  const int tid = opaque_tid(), lane = tid & 63, w = tid >> 6, l15 = lane & 15, quad = lane >> 4;
  char* const WS = opaque_ws(p.ws);
  const int BID = opaque_bid(); (void)BID;
  const int nqb = T / QB;
  const int qblk = nqb - 1 - item / (NB * NH);
  const int bh = item % (NB * NH);
  const int b = bh / NH, h = bh % NH;
  const int q0 = qblk * QB;
  float* tab = (float*)smem;
  u16* sK = (u16*)(smem + 8320);
  const u16* Qg = (const u16*)(WS + OFF_GRP) + (size_t)(GQ + 0) * (SZ_GRP / 2);
  const u16* Kg = (const u16*)(WS + OFF_GRP) + (size_t)(GQ + 1) * (SZ_GRP / 2);
  const u16* Vt = (const u16*)(WS + OFF_GRP) + (size_t)(GQ + 2) * (SZ_GRP / 2);
  u16* Yg = (u16*)(WS + OFF_GRP) + (size_t)(GQ + 3) * (SZ_GRP / 2);

  __syncthreads();
  for (int d = tid; d < 2050; d += NTHREADS) {
    float v;
    if (d == 2049) v = NEG_INF;
    else {
      float bias = p.rel_bias[t5_bucket(d) * 12 + (IS_A ? h : 8 + h)];
      if (IS_A) {
        int m = (d <= 128 ? 1 : 0) + (((d & 3) == 0 && d <= 512) ? 1 : 0) + (((d & 15) == 0) ? 1 : 0);
        v = m ? bias + logf((float)m) : NEG_INF;
      } else v = bias;
    }
    tab[d] = v;
  }
  const int map = NMAP == 2 ? (w >> 2) : 0;
  const int wq = (NMAP == 2 ? (w & 3) : w) * 32;
  bf16x8 qf[2][2];
#pragma unroll
  for (int qt = 0; qt < 2; qt++)
#pragma unroll
    for (int ks = 0; ks < 2; ks++)
      qf[qt][ks] = ld8(Qg + (size_t)(b * T + q0 + wq + qt * 16 + l15) * 512 + h * HW + map * 64 + ks * 32 + quad * 8);

  f32x4 ot[NDT][2];
#pragma unroll
  for (int i = 0; i < NDT; i++) { ot[i][0] = zero4(); ot[i][1] = zero4(); }
  float mrun[2] = {NEG_INF, NEG_INF}, lrun[2] = {0.f, 0.f};

  int lo = IS_A ? (q0 - 2048 > 0 ? q0 - 2048 : 0) : 0;
  const int kt_lo = lo / 64, kt_hi = (q0 + QB) / 64;
  constexpr int NKC = NMAP * 512 / NTHREADS;
  constexpr int NVC = DV * 8 / NTHREADS;
  uint4 rk0, rk1, rv0, rv1;
  rk1 = make_uint4(0,0,0,0); rv1 = rk1;
  const u16 *pk0, *pk1, *pv0, *pv1;
  { int c = tid; int mc = c >> 9, row = (c & 511) >> 3, kc = c & 7;
    pk0 = Kg + (size_t)(b * T + row) * 512 + h * HW + mc * 64 + kc * 8;
    c = tid + NTHREADS; mc = c >> 9; row = (c & 511) >> 3; kc = c & 7;
    pk1 = Kg + (size_t)(b * T + row) * 512 + h * HW + mc * 64 + kc * 8;
    c = tid; int dv = c >> 3; kc = c & 7;
    pv0 = Vt + ((size_t)(b * 512 + h * DV + dv)) * T + kc * 8;
    c = tid + NTHREADS; dv = c >> 3; kc = c & 7;
    pv1 = Vt + ((size_t)(b * 512 + h * DV + dv)) * T + kc * 8; }
#define LOADKV(KT) { const size_t s0_ = (size_t)(KT) * 64; rk0 = *(const uint4*)(pk0 + s0_ * 512); if (NKC > 1) rk1 = *(const uint4*)(pk1 + s0_ * 512); \
                     rv0 = *(const uint4*)(pv0 + s0_); if (NVC > 1) rv1 = *(const uint4*)(pv1 + s0_); }
  constexpr int KST = NMAP * 64 * LP;
  constexpr int VST = DV * LP;
#define STK_(i_, src_) { int c = tid + NTHREADS * (i_); int mc = c >> 9, row = (c & 511) >> 3, kc = c & 7; *(uint4*)(sKw + (mc * 64 + row) * LP + kc * 8) = src_; }
#define STV_(i_, src_) { int c = tid + NTHREADS * (i_); int dv = c >> 3, kc = c & 7; *(uint4*)(sVw + dv * LP + kc * 8) = src_; }
#define STOREKV(ks_, vs_) { u16* sKw = sK0 + (ks_) * KST; u16* sVw = sV0 + (vs_) * VST; STK_(0, rk0); if (NKC > 1) STK_(1, rk1); STV_(0, rv0); if (NVC > 1) STV_(1, rv1); }
  u16* const sK0 = sK;
  u16* const sV0 = sK + 2 * KST;
  const bool late = (NMAP == 2) && (map == 1);
  LOADKV(kt_lo);
  STOREKV(0, 0);
  if (kt_lo + 1 < kt_hi) LOADKV(kt_lo + 1);
  RAW_BARRIER();
  int kcur = 0, vcur = 0, vprev = 0;
  bf16x8 pf[2][2];
#pragma unroll
  for (int a_ = 0; a_ < 2; a_++)
#pragma unroll
    for (int b_ = 0; b_ < 2; b_++) { bf16x8 z8 = {0, 0, 0, 0, 0, 0, 0, 0}; pf[a_][b_] = z8; }
  for (int kt = kt_lo; kt < kt_hi; kt++) {
    const u16* sK = sK0 + kcur * KST;
    const u16* sV = sV0 + vcur * VST;
    if (late && kt > kt_lo) pv_accum<NDT>(ot, pf, sV0 + vprev * VST, l15, quad);
    const int s0 = kt * 64;
    f32x4 st[2][4];
#pragma unroll
    for (int qt = 0; qt < 2; qt++)
#pragma unroll
      for (int k4 = 0; k4 < 4; k4++) st[qt][k4] = zero4();
    {
      bf16x8 kf[4][2];
#pragma unroll
      for (int k4 = 0; k4 < 4; k4++)
#pragma unroll
        for (int ks = 0; ks < 2; ks++) kf[k4][ks] = ld8(sK + (map * 64 + k4 * 16 + l15) * LP + ks * 32 + quad * 8);
      __builtin_amdgcn_sched_barrier(0);
#pragma unroll
      for (int k4 = 0; k4 < 4; k4++)
#pragma unroll
        for (int ks = 0; ks < 2; ks++)
#pragma unroll
          for (int qt = 0; qt < 2; qt++) st[qt][k4] = mfma16(kf[k4][ks], qf[qt][ks], st[qt][k4]);
      __builtin_amdgcn_sched_barrier(0);
    }
    float alpha[2];
    const bool far = !IS_A && (s0 + 63 + 2048 <= q0);
    const bool sparse4 = IS_A && (q0 - s0 - 63 > 128);
    if (far) {
      const float cb = tab[2048];
#pragma unroll
      for (int qt = 0; qt < 2; qt++) {
        float mx = NEG_INF;
#pragma unroll
        for (int k4 = 0; k4 < 4; k4++)
#pragma unroll
          for (int j = 0; j < 4; j++) mx = fmaxf(mx, st[qt][k4][j]);
        mx = quad_allmax(mx);
        const float mnew = fmaxf(mrun[qt], mx * 0.125f + cb);
        alpha[qt] = __builtin_amdgcn_exp2f((mrun[qt] - mnew) * 1.4426950408889634f);
        mrun[qt] = mnew;
        const float c2 = (cb - mnew) * 1.4426950408889634f;
        float rsum = 0.f;
#pragma unroll
        for (int k4 = 0; k4 < 4; k4++)
#pragma unroll
          for (int j = 0; j < 4; j++) { float e = __builtin_amdgcn_exp2f(fmaf(st[qt][k4][j], 0.125f * 1.4426950408889634f, c2)); st[qt][k4][j] = e; rsum += e; }
        lrun[qt] = lrun[qt] * alpha[qt] + rsum;
      }
    } else if (sparse4) {
      const int jsel = l15 & 3;
#pragma unroll
      for (int qt = 0; qt < 2; qt++) {
        const int dbase = q0 + wq + qt * 16 + l15 - s0 - quad * 4 - jsel;
        float cand[4];
        float mx = NEG_INF;
#pragma unroll
        for (int k4 = 0; k4 < 4; k4++) {
          float e01 = (jsel & 1) ? st[qt][k4][1] : st[qt][k4][0];
          float e23 = (jsel & 1) ? st[qt][k4][3] : st[qt][k4][2];
          float e = (jsel & 2) ? e23 : e01;
          int d = dbase - k4 * 16;
          int di = d < LIM ? d : LIM;
          float sv = e * 0.125f + tab[di];
          cand[k4] = sv;
          mx = fmaxf(mx, sv);
        }
        mx = quad_allmax(mx);
        const float mnew = fmaxf(mrun[qt], mx);
        const float msafe = (mnew == NEG_INF) ? 0.f : mnew;
        alpha[qt] = __expf(mrun[qt] - msafe);
        mrun[qt] = mnew;
        float rsum = 0.f;
        unsigned pu[4][2];
#pragma unroll
        for (int k4 = 0; k4 < 4; k4++) {
          float e = __expf(cand[k4] - msafe);
          rsum += e;
          unsigned pb = pack2_nop(e, 0.f) << ((jsel & 1) * 16);
          pu[k4][0] = (jsel & 2) ? 0u : pb;
          pu[k4][1] = (jsel & 2) ? pb : 0u;
        }
        lrun[qt] = lrun[qt] * alpha[qt] + rsum;
#pragma unroll
        for (int g = 0; g < 2; g++) {
          uint4 uu = make_uint4(pu[2 * g][0], pu[2 * g][1], pu[2 * g + 1][0], pu[2 * g + 1][1]);
          pf[qt][g] = __builtin_bit_cast(bf16x8, uu);
        }
      }
    } else {
#pragma unroll
      for (int qt = 0; qt < 2; qt++) {
        const int dq = q0 + wq + qt * 16 + l15 - s0 - quad * 4;
        float mx = NEG_INF;
#pragma unroll
        for (int k4 = 0; k4 < 4; k4++) {
          float tv[4];
#pragma unroll
          for (int j = 0; j < 4; j++) {
            int d = dq - k4 * 16 - j;
            d = d < 0 ? 0 : d;
            tv[j] = tab[d < LIM ? d : LIM];
          }
#pragma unroll
          for (int j = 0; j < 4; j++) {
            const int d = dq - k4 * 16 - j;
            float sv = fmaf(st[qt][k4][j], 0.125f, tv[j]);
            sv = d < 0 ? NEG_INF : sv;
            st[qt][k4][j] = sv;
            mx = fmaxf(mx, sv);
          }
        }
        mx = quad_allmax(mx);
        const float mnew = fmaxf(mrun[qt], mx);
        const float msafe = (mnew == NEG_INF) ? 0.f : mnew;
        alpha[qt] = __expf(mrun[qt] - msafe);
        mrun[qt] = mnew;
        float rsum = 0.f;
#pragma unroll
        for (int k4 = 0; k4 < 4; k4++)
#pragma unroll
          for (int j = 0; j < 4; j++) { float e = __expf(st[qt][k4][j] - msafe); st[qt][k4][j] = e; rsum += e; }
        lrun[qt] = lrun[qt] * alpha[qt] + rsum;
      }
    }
    if (__any((alpha[0] != 1.f) || (alpha[1] != 1.f))) {
#pragma unroll
      for (int qt = 0; qt < 2; qt++)
#pragma unroll
        for (int i = 0; i < NDT; i++) { ot[i][qt][0] *= alpha[qt]; ot[i][qt][1] *= alpha[qt]; ot[i][qt][2] *= alpha[qt]; ot[i][qt][3] *= alpha[qt]; }
    }
    if (!sparse4)
#pragma unroll
    for (int qt = 0; qt < 2; qt++)
#pragma unroll
      for (int g = 0; g < 2; g++) {
        unsigned u0 = pack2(st[qt][2 * g][0], st[qt][2 * g][1]), u1 = pack2(st[qt][2 * g][2], st[qt][2 * g][3]);
        unsigned u2 = pack2(st[qt][2 * g + 1][0], st[qt][2 * g + 1][1]), u3 = pack2(st[qt][2 * g + 1][2], st[qt][2 * g + 1][3]);
        uint4 uu = make_uint4(u0, u1, u2, u3);
        pf[qt][g] = __builtin_bit_cast(bf16x8, uu);
      }
    if (!late) pv_accum<NDT>(ot, pf, sV, l15, quad);
    {
      const int vnext = (vcur == 2) ? 0 : vcur + 1;
      if (kt + 1 < kt_hi) STOREKV(kcur ^ 1, vnext);
      if (kt + 2 < kt_hi) LOADKV(kt + 2);
      RAW_BARRIER();
      kcur ^= 1; vprev = vcur; vcur = vnext;
    }
  }
  if (late) pv_accum<NDT>(ot, pf, sV0 + vprev * VST, l15, quad);
  float inv[2];
#pragma unroll
  for (int qt = 0; qt < 2; qt++) {
    float l = lrun[qt];
    l = quad_allsum(l);
    inv[qt] = 1.f / l;
  }
  if (IS_A) {
#pragma unroll
    for (int qt = 0; qt < 2; qt++) {
      const size_t tok = (size_t)(b * T + q0 + wq + qt * 16 + l15);
#pragma unroll
      for (int i = 0; i < NDT; i++) {
        u16* yp = Yg + tok * 512 + h * DV + i * 16 + quad * 4;
        uint2 gz = *(const uint2*)yp;
        float g0 = bf2f((u16)(gz.x & 0xffff)), g1 = bf2f((u16)(gz.x >> 16)), g2 = bf2f((u16)(gz.y & 0xffff)), g3 = bf2f((u16)(gz.y >> 16));
        float o0 = ot[i][qt][0] * inv[qt] * siluf_(g0), o1 = ot[i][qt][1] * inv[qt] * siluf_(g1);
        float o2 = ot[i][qt][2] * inv[qt] * siluf_(g2), o3 = ot[i][qt][3] * inv[qt] * siluf_(g3);
        *(uint2*)yp = make_uint2(pack2(o0, o1), pack2(o2, o3));
      }
    }
  } else {
    const float lam_init = 0.8f - 0.6f * expf(-0.3f * (float)layer);
    const float lam = ((const float*)(WS + OFF_CNT))[32 + layer];
    float* sO2 = (float*)smem;
    __syncthreads();
    if (map == 1) {
#pragma unroll
      for (int qt = 0; qt < 2; qt++)
#pragma unroll
        for (int i = 0; i < NDT; i++)
#pragma unroll
          for (int j = 0; j < 4; j++) sO2[(wq + qt * 16 + l15) * 132 + i * 16 + quad * 4 + j] = ot[i][qt][j] * inv[qt];
    }
    __syncthreads();
    if (map == 0) {
      const float* sg = p.diff_subln + layer * 128;
#pragma unroll
      for (int qt = 0; qt < 2; qt++) {
        float ss = 0.f;
#pragma unroll
        for (int i = 0; i < NDT; i++)
#pragma unroll
          for (int j = 0; j < 4; j++) {
            float o = ot[i][qt][j] * inv[qt] - lam * sO2[(wq + qt * 16 + l15) * 132 + i * 16 + quad * 4 + j];
            ot[i][qt][j] = o; ss += o * o;
          }
        ss = quad_allsum(ss);
        const float r = rsqrtf(ss * (1.f / 128.f) + 1e-6f) * (1.f - lam_init);
        const size_t tok = (size_t)(b * T + q0 + wq + qt * 16 + l15);
#pragma unroll
        for (int i = 0; i < NDT; i++) {
          const int dv = i * 16 + quad * 4;
          u16* yp = Yg + tok * 512 + h * DV + dv;
          uint2 gz = *(const uint2*)yp;
          float g0 = bf2f((u16)(gz.x & 0xffff)), g1 = bf2f((u16)(gz.x >> 16)), g2 = bf2f((u16)(gz.y & 0xffff)), g3 = bf2f((u16)(gz.y >> 16));
          float o0 = ot[i][qt][0] * r * sg[dv + 0] * siluf_(g0), o1 = ot[i][qt][1] * r * sg[dv + 1] * siluf_(g1);
          float o2 = ot[i][qt][2] * r * sg[dv + 2] * siluf_(g2), o3 = ot[i][qt][3] * r * sg[dv + 3] * siluf_(g3);
          *(uint2*)yp = make_uint2(pack2(o0, o1), pack2(o2, o3));
        }
      }
    }
  }
}

DI void c_prepass(const Params& p, int layer, int ci, char* smem) {
  const int tid = opaque_tid(), lane = tid & 63, w = tid >> 6, l15 = lane & 15, quad = lane >> 4;
  char* const WS = opaque_ws(p.ws);
  const int BID = opaque_bid(); (void)BID;
  const int n = ci & 255, bh = ci >> 8, b = bh >> 2, h = bh & 3;
  const int t0 = n * 64;
  const size_t tok0 = (size_t)b * T + t0;
  u16* sQb = (u16*)smem;
  u16* sKb = sQb + 64 * 136;
  u16* sVbT = sKb + 64 * 136;
  u16* sKbT = sVbT + 128 * 72;
  char* r2 = (char*)(sKbT + 128 * 72);
  u16* sKdT = (u16*)r2;
  float* sM = (float*)r2;
  u16* sTb = (u16*)(sM + 64 * 68 + 64);
  float* sG = (float*)(sTb + 64 * 72);
  float* sBeta = sG + 64;
  const u16* grp = (const u16*)(WS + OFF_GRP);
  const float* bd = (const float*)(WS + OFF_BD);
  __syncthreads();
  if (w == 0) {
    const float* bdr = bd + (tok0 + lane) * 8;
    float beta = sigmoidf_(bdr[h]);
    float xa = bdr[4 + h] + p.dn_dt_bias[layer * 4 + h];
    float sp = xa > 20.f ? xa : log1pf(expf(xa));
    float g = -expf(p.dn_a_log[layer * 4 + h]) * sp;
#pragma unroll
    for (int o = 1; o < 64; o <<= 1) { float t = __shfl_up(g, o); if (lane >= o) g += t; }
    sG[lane] = g; sBeta[lane] = beta;
  }
  __syncthreads();
  const float Glast = sG[63];
  {
    const float* cw = p.dn_conv + (size_t)layer * 4 * 1536;
    u16* cQ = (u16*)(WS + OFF_CQ) + (size_t)ci * 8192;
    const int i0 = w * 8;
    const int ch = h * 128 + 2 * lane;
    float v6[8][6];
#pragma unroll
    for (int part = 0; part < 3; part++) {
      const u16* src = grp + (size_t)(8 + part) * (SZ_GRP / 2);
      unsigned xin[11];
#pragma unroll
      for (int r = 0; r < 11; r++) {
        const int tl = t0 + i0 - 3 + r;
        xin[r] = tl >= 0 ? *(const unsigned*)(src + ((size_t)b * T + tl) * 512 + ch) : 0u;
      }
      float2 wj[4];
#pragma unroll
      for (int j = 0; j < 4; j++) wj[j] = *(const float2*)(cw + j * 1536 + part * 512 + ch);
#pragma unroll
      for (int ii = 0; ii < 8; ii++) {
        float a0 = 0.f, a1 = 0.f;
#pragma unroll
        for (int j = 0; j < 4; j++) {
          a0 += wj[j].x * __uint_as_float(xin[ii + j] << 16);
          a1 += wj[j].y * __uint_as_float(xin[ii + j] & 0xffff0000u);
        }
        v6[ii][part * 2] = siluf_(a0);
        v6[ii][part * 2 + 1] = siluf_(a1);
      }
    }
#pragma unroll
    for (int ii = 0; ii < 8; ii++) {
      const int i = i0 + ii;
      float sq = wave_sum(v6[ii][0] * v6[ii][0] + v6[ii][1] * v6[ii][1]);
      float sk = wave_sum(v6[ii][2] * v6[ii][2] + v6[ii][3] * v6[ii][3]);
      const float rq = rsqrtf(sq + 1e-6f) * 0.08838834764831845f, rk = rsqrtf(sk + 1e-6f);
      const float Gi = sG[i], bi = sBeta[i];
      const float eG = __expf(Gi), eGl = __expf(Glast - Gi);
      const float q0 = v6[ii][0] * rq, q1 = v6[ii][1] * rq, k0 = v6[ii][2] * rk, k1 = v6[ii][3] * rk;
      const int dd = 2 * lane;
      *(unsigned*)(sQb + i * 136 + dd) = pack2(q0, q1);
      *(unsigned*)(sKb + i * 136 + dd) = pack2(k0, k1);
      *(unsigned*)(cQ + i * 128 + dd) = pack2(q0 * eG, q1 * eG);
      sVbT[dd * 72 + i] = f2bf(v6[ii][4] * bi);
      sVbT[(dd + 1) * 72 + i] = f2bf(v6[ii][5] * bi);
      sKbT[dd * 72 + i] = f2bf(k0 * bi * eG);
      sKbT[(dd + 1) * 72 + i] = f2bf(k1 * bi * eG);
      sKdT[dd * 72 + i] = f2bf(k0 * eGl);
      sKdT[(dd + 1) * 72 + i] = f2bf(k1 * eGl);
    }
  }
  __syncthreads();
  {
    u16* cKd = (u16*)(WS + OFF_CKD) + (size_t)ci * 8192;
#pragma unroll
    for (int i = 0; i < 2; i++) { int c = tid + NTHREADS * i; int row = c >> 3, kc = c & 7; *(uint4*)(cKd + row * 64 + kc * 8) = *(const uint4*)(sKdT + row * 72 + kc * 8); }
    if (tid < 128) ((float*)(WS + OFF_CDEC))[(size_t)ci * 128 + tid] = __expf(Glast);
  }
  f32x4 akk[2], aqk[2];
#pragma unroll
  for (int tt = 0; tt < 2; tt++) {
    const int tile = w + 8 * tt, rt = tile >> 2, ct = tile & 3;
    akk[tt] = zero4(); aqk[tt] = zero4();
#pragma unroll
    for (int ks = 0; ks < 4; ks++) {
      bf16x8 bk = ld8(sKb + (ct * 16 + l15) * 136 + ks * 32 + quad * 8);
      bf16x8 ak = ld8(sKb + (rt * 16 + l15) * 136 + ks * 32 + quad * 8);
      bf16x8 aq = ld8(sQb + (rt * 16 + l15) * 136 + ks * 32 + quad * 8);
      akk[tt] = mfma16(ak, bk, akk[tt]);
      aqk[tt] = mfma16(aq, bk, aqk[tt]);
    }
  }
  __syncthreads();
  {
    u16* cA = (u16*)(WS + OFF_CA) + (size_t)ci * 4096;
#pragma unroll
    for (int tt = 0; tt < 2; tt++) {
      const int tile = w + 8 * tt, rt = tile >> 2, ct = tile & 3;
      const int jc = ct * 16 + l15;
      const float Gj = sG[jc];
#pragma unroll
      for (int j = 0; j < 4; j++) {
        const int ir = rt * 16 + quad * 4 + j;
        const float gam = jc <= ir ? __expf(sG[ir] - Gj) : 0.f;
        sM[ir * 68 + jc] = jc < ir ? sBeta[ir] * akk[tt][j] * gam : 0.f;
        cA[ir * 64 + jc] = f2bf(aqk[tt][j] * gam);
      }
    }
  }
  __syncthreads();
  if (w == 0) {
    float tc[64];
#pragma unroll
    for (int i = 0; i < 64; i++) {
      float sp[4] = {(i == lane) ? 1.f : 0.f, 0.f, 0.f, 0.f};
#pragma unroll
      for (int j = 0; j < i; j++) sp[j & 3] -= sM[i * 68 + j] * tc[j];
      const float s = (sp[0] + sp[1]) + (sp[2] + sp[3]);
      tc[i] = s;
      sTb[i * 72 + lane] = f2bf(s);
    }
  }
  __syncthreads();
  {
    u16* cU = (u16*)(WS + OFF_CU);
    u16* cW = (u16*)(WS + OFF_CW) + (size_t)ci * 8192;
    const int ct = w;
#pragma unroll
    for (int rt = 0; rt < 4; rt++) {
      f32x4 au = zero4(), aw = zero4();
#pragma unroll
      for (int ks = 0; ks < 2; ks++) {
        bf16x8 at = ld8(sTb + (rt * 16 + l15) * 72 + ks * 32 + quad * 8);
        bf16x8 bv = ld8(sVbT + (ct * 16 + l15) * 72 + ks * 32 + quad * 8);
        bf16x8 bk = ld8(sKbT + (ct * 16 + l15) * 72 + ks * 32 + quad * 8);
        au = mfma16(at, bv, au);
        aw = mfma16(at, bk, aw);
      }
      *(uint2*)(cU + ((size_t)(b * 512 + h * 128 + ct * 16 + l15)) * T + t0 + rt * 16 + quad * 4) = make_uint2(pack2_safe(au[0], au[1]), pack2_safe(au[2], au[3]));
#pragma unroll
      for (int j = 0; j < 4; j++) {
        const int ir = rt * 16 + quad * 4 + j;
        cW[ir * 128 + ct * 16 + l15] = f2bf(aw[j]);
      }
    }
  }
}

DI void d_prepass(const Params& p, int layer, int ci, char* smem) {
  const int tid = opaque_tid(), lane = tid & 63, w = tid >> 6, l15 = lane & 15, quad = lane >> 4;
  char* const WS = opaque_ws(p.ws);
  const int BID = opaque_bid(); (void)BID;
  const int n = ci & 255, bh = ci >> 8, b = bh >> 2, h = bh & 3;
  const size_t tok0 = (size_t)b * T + n * 64;
  float* sBc = (float*)smem;
  float* sKv = sBc + 64 * 128;
  u16* sQh = (u16*)(sKv + 64 * 128);
  u16* sKh = sQh + 64 * 136;
  u16* sKdT = sKh + 64 * 136;
  float* sPart = (float*)(sKdT + 128 * 72);
  u16* grp = (u16*)(WS + OFF_GRP);
  u16* dq = grp + (size_t)12 * (SZ_GRP / 2);
  const u16* df = grp + (size_t)13 * (SZ_GRP / 2);
  __syncthreads();
  const int d = tid & 127, qtr = tid >> 7;
  float lb = 0.f;
  if (layer == 1) lb = sigmoidf_(p.hg_lb_logits[512 + h * 128 + d] - p.hg_lb_logits[h * 128 + d]);
  lb = fminf(fmaxf(lb, 0.f), 1.f);
  {
    float run = 0.f;
    for (int r = 0; r < 16; r++) {
      const int i = qtr * 16 + r;
      float fr = bf2f(df[(tok0 + i) * 512 + h * 128 + d]);
      float kk = (1.f - lb) * sigmoidf_(-fr);
      float lf = __logf(1.f - kk);
      run += lf;
      sBc[i * 128 + d] = run;
      sKv[i * 128 + d] = kk;
    }
    sPart[qtr * 128 + d] = run;
  }
  __syncthreads();
  {
    float off = 0.f;
    for (int q2 = 0; q2 < qtr; q2++) off += sPart[q2 * 128 + d];
    for (int r = 0; r < 16; r++) sBc[(qtr * 16 + r) * 128 + d] += off;
  }
  __syncthreads();
  {
    const float bl = sBc[63 * 128 + d], bm = sBc[31 * 128 + d];
    for (int r = 0; r < 16; r++) {
      const int i = qtr * 16 + r;
      const float bc = sBc[i * 128 + d], kk = sKv[i * 128 + d];
      u16* qp = dq + (tok0 + i) * 512 + h * 128 + d;
      const float q = bf2f(*qp);
      *qp = f2bf(q * __expf(bc));
      sQh[i * 136 + d] = f2bf(q * __expf(bc - bm));
      sKh[i * 136 + d] = f2bf(kk * __expf(bm - bc));
      sKdT[d * 72 + i] = f2bf(kk * __expf(bl - bc));
    }
    if (qtr == 0) ((float*)(WS + OFF_DDEC))[(size_t)ci * 128 + d] = __expf(bl);
  }
  __syncthreads();
  {
    u16* dKd = (u16*)(WS + OFF_DKD) + (size_t)ci * 8192;
#pragma unroll
    for (int i = 0; i < 2; i++) { int c = tid + NTHREADS * i; int row = c >> 3, kc = c & 7; *(uint4*)(dKd + row * 64 + kc * 8) = *(const uint4*)(sKdT + row * 72 + kc * 8); }
    u16* dA = (u16*)(WS + OFF_DA) + (size_t)ci * 4096;
#pragma unroll
    for (int tt = 0; tt < 2; tt++) {
      const int tile = w + 8 * tt, rt = tile >> 2, ct = tile & 3;
      f32x4 a = zero4();
#pragma unroll
      for (int ks = 0; ks < 4; ks++) {
        bf16x8 aq = ld8(sQh + (rt * 16 + l15) * 136 + ks * 32 + quad * 8);
        bf16x8 bk = ld8(sKh + (ct * 16 + l15) * 136 + ks * 32 + quad * 8);
        a = mfma16(aq, bk, a);
      }
      const int jc = ct * 16 + l15;
#pragma unroll
      for (int j = 0; j < 4; j++) {
        const int ir = rt * 16 + quad * 4 + j;
        dA[ir * 64 + jc] = f2bf(jc <= ir ? a[j] : 0.f);
      }
    }
  }
}

struct ScanRegs {
  bf16x8 wf[4], qf[4], af[2], kdf[2];
  float decv;
  uint2 u[2];
};

template <bool DELTA>
DI void scan_load(ScanRegs& r, const u16* U, const u16* W, const u16* Q, int ldq, const u16* KdT, const u16* A, const float* dec,
                  int rt, int cbase, int w, int l15, int quad) {
#pragma unroll
  for (int ks = 0; ks < 4; ks++) {
    if (DELTA) r.wf[ks] = ld8(W + (rt * 16 + l15) * 128 + ks * 32 + quad * 8);
    r.qf[ks] = ld8(Q + (size_t)(rt * 16 + l15) * ldq + ks * 32 + quad * 8);
  }
#pragma unroll
  for (int ks = 0; ks < 2; ks++) {
    r.af[ks] = ld8(A + (rt * 16 + l15) * 64 + ks * 32 + quad * 8);
    r.kdf[ks] = ld8(KdT + (w * 16 + l15) * 64 + ks * 32 + quad * 8);
  }
  r.decv = dec[w * 16 + l15];
#pragma unroll
  for (int c2 = 0; c2 < 2; c2++) r.u[c2] = *(const uint2*)(U + (size_t)((cbase + c2) * 16 + l15) * T + rt * 16 + quad * 4);
}

template <bool DELTA>
DI void scan_item(const Params& p, int layer, int item, char* smem) {
  const int tid = opaque_tid(), lane = tid & 63, w = tid >> 6, l15 = lane & 15, quad = lane >> 4;
  char* const WS = opaque_ws(p.ws);
  const int BID = opaque_bid(); (void)BID;
  const int bh = item >> 1, half = item & 1;
  const int b = bh >> 2, h = bh & 3;
  u16* sSt = (u16*)smem;
  u16* sVnT = sSt + 2 * 64 * 136;
  u16* grp = (u16*)(WS + OFF_GRP);
  const u16* Ubase = DELTA ? (const u16*)(WS + OFF_CU) : grp + (size_t)14 * (SZ_GRP / 2);
  u16* Obase = grp + (size_t)(DELTA ? 8 : 13) * (SZ_GRP / 2);
  const int rt = w >> 1, cbase = (w & 1) * 2;
  const int colofs = h * 128 + half * 64;
  __syncthreads();
  for (int e = tid; e < 64 * 136; e += NTHREADS) sSt[e] = 0;
  f32x4 accS[4];
#pragma unroll
  for (int i = 0; i < 4; i++) accS[i] = zero4();
  ScanRegs cur, nxt;
#define SCAN_LOAD(R, N) { \
      const size_t ci_ = (size_t)bh * 256 + (N); \
      const size_t tk_ = (size_t)b * T + (N) * 64; \
      const u16* U_ = Ubase + ((size_t)(b * 512 + colofs)) * T + (N) * 64; \
      const u16* Wp_ = (const u16*)(WS + OFF_CW) + ci_ * 8192; \
      const u16* Qp_ = DELTA ? (const u16*)(WS + OFF_CQ) + ci_ * 8192 : grp + (size_t)12 * (SZ_GRP / 2) + tk_ * 512 + h * 128; \
      const u16* Kd_ = (const u16*)(WS + (DELTA ? OFF_CKD : OFF_DKD)) + ci_ * 8192; \
      const u16* Ap_ = (const u16*)(WS + (DELTA ? OFF_CA : OFF_DA)) + ci_ * 4096; \
      const float* dc_ = (const float*)(WS + (DELTA ? OFF_CDEC : OFF_DDEC)) + ci_ * 128; \
      scan_load<DELTA>(R, U_, Wp_, Qp_, DELTA ? 128 : 512, Kd_, Ap_, dc_, rt, cbase, w, l15, quad); }
  SCAN_LOAD(cur, 0);
  __syncthreads();
  int sb = 0;
  for (int n = 0; n < 256; n++) {
    if (n + 1 < 256) SCAN_LOAD(nxt, n + 1);
    const u16* sStc = sSt + sb * 64 * 136;
    u16* sStn = sSt + (sb ^ 1) * 64 * 136;
    bf16x8 sf[2][4];
#pragma unroll
    for (int c2 = 0; c2 < 2; c2++)
#pragma unroll
      for (int ks = 0; ks < 4; ks++) sf[c2][ks] = ld8(sStc + ((cbase + c2) * 16 + l15) * 136 + ks * 32 + quad * 8);
    __builtin_amdgcn_sched_barrier(0);
#pragma unroll
    for (int c2 = 0; c2 < 2; c2++) {
      const int ct = cbase + c2;
      float vn[4];
      if (DELTA) {
        f32x4 a = zero4();
#pragma unroll
        for (int ks = 0; ks < 4; ks++) a = mfma16(cur.wf[ks], sf[c2][ks], a);
        vn[0] = __uint_as_float(cur.u[c2].x << 16) - a[0]; vn[1] = __uint_as_float(cur.u[c2].x & 0xffff0000u) - a[1];
        vn[2] = __uint_as_float(cur.u[c2].y << 16) - a[2]; vn[3] = __uint_as_float(cur.u[c2].y & 0xffff0000u) - a[3];
      } else {
        vn[0] = __uint_as_float(cur.u[c2].x << 16); vn[1] = __uint_as_float(cur.u[c2].x & 0xffff0000u);
        vn[2] = __uint_as_float(cur.u[c2].y << 16); vn[3] = __uint_as_float(cur.u[c2].y & 0xffff0000u);
      }
      *(uint2*)(sVnT + (ct * 16 + l15) * 72 + rt * 16 + quad * 4) = make_uint2(pack2(vn[0], vn[1]), pack2(vn[2], vn[3]));
    }
    RAW_BARRIER();
    {
      const size_t tok0 = (size_t)b * T + n * 64;
      bf16x8 vf2[2][2], vf3[4][2];
#pragma unroll
      for (int c2 = 0; c2 < 2; c2++)
#pragma unroll
        for (int ks = 0; ks < 2; ks++) vf2[c2][ks] = ld8(sVnT + ((cbase + c2) * 16 + l15) * 72 + ks * 32 + quad * 8);
#pragma unroll
      for (int dvt = 0; dvt < 4; dvt++)
#pragma unroll
        for (int ks = 0; ks < 2; ks++) vf3[dvt][ks] = ld8(sVnT + (dvt * 16 + l15) * 72 + ks * 32 + quad * 8);
      __builtin_amdgcn_sched_barrier(0);
#pragma unroll
      for (int c2 = 0; c2 < 2; c2++) {
        const int ct = cbase + c2;
        f32x4 a = zero4();
#pragma unroll
        for (int ks = 0; ks < 4; ks++) a = mfma16(cur.qf[ks], sf[c2][ks], a);
#pragma unroll
        for (int ks = 0; ks < 2; ks++) a = mfma16(cur.af[ks], vf2[c2][ks], a);
#pragma unroll
        for (int j = 0; j < 4; j++) Obase[(tok0 + rt * 16 + quad * 4 + j) * 512 + colofs + ct * 16 + l15] = f2bf(a[j]);
      }
#pragma unroll
      for (int dvt = 0; dvt < 4; dvt++) {
        f32x4 a = accS[dvt];
        a[0] *= cur.decv; a[1] *= cur.decv; a[2] *= cur.decv; a[3] *= cur.decv;
#pragma unroll
        for (int ks = 0; ks < 2; ks++) a = mfma16(vf3[dvt][ks], cur.kdf[ks], a);
        accS[dvt] = a;
#pragma unroll
        for (int j = 0; j < 4; j++) sStn[(dvt * 16 + quad * 4 + j) * 136 + w * 16 + l15] = f2bf(a[j]);
      }
    }
    RAW_BARRIER();
    sb ^= 1;
    if (n + 1 < 256) cur = nxt;
  }
#undef SCAN_LOAD
}

DI void scan_post(const Params& p, int layer) {
  const int tid = opaque_tid(), lane = tid & 63, w = tid >> 6;
  char* const WS = opaque_ws(p.ws);
  const int BID = opaque_bid(); (void)BID;
  u16* grp = (u16*)(WS + OFF_GRP);
  const int head = lane >> 4, sub = lane & 15;
  for (int r = BID * 8 + w; r < 2 * NT; r += gridDim.x * 8) {
    const int mixer = r >= NT ? 1 : 0;
    const size_t tok = (size_t)(r - mixer * NT);
    const u16* O = grp + (size_t)(mixer ? 13 : 8) * (SZ_GRP / 2) + tok * 512 + head * 128 + sub * 8;
    u16* Z = grp + (size_t)(mixer ? 15 : 11) * (SZ_GRP / 2) + tok * 512 + head * 128 + sub * 8;
    const float* gain = (mixer ? p.hg_norm_gain : p.dn_norm_gain) + layer * 128 + sub * 8;
    uint4 ov = *(const uint4*)O, zv = *(const uint4*)Z;
    unsigned oo[4] = {ov.x, ov.y, ov.z, ov.w}, zz[4] = {zv.x, zv.y, zv.z, zv.w};
    float of[8], zf[8];
#pragma unroll
    for (int i = 0; i < 4; i++) {
      of[2 * i] = __uint_as_float(oo[i] << 16); of[2 * i + 1] = __uint_as_float(oo[i] & 0xffff0000u);
      zf[2 * i] = __uint_as_float(zz[i] << 16); zf[2 * i + 1] = __uint_as_float(zz[i] & 0xffff0000u);
    }
    float ss = 0.f;
#pragma unroll
    for (int i = 0; i < 8; i++) ss += of[i] * of[i];
    ROW_ROR_ADD(ss, 8); ROW_ROR_ADD(ss, 4); ROW_ROR_ADD(ss, 2); ROW_ROR_ADD(ss, 1);
    const float rr = rsqrtf(ss * (1.f / 128.f) + 1e-6f);
    float y[8];
#pragma unroll
    for (int i = 0; i < 8; i++) y[i] = of[i] * rr * gain[i] * siluf_(zf[i]);
    *(uint4*)Z = make_uint4(pack2(y[0], y[1]), pack2(y[2], y[3]), pack2(y[4], y[5]), pack2(y[6], y[7]));
  }
}

DI void phase3(const Params& p, char* smem) {
  const int tid = opaque_tid(), lane = tid & 63, w = tid >> 6, wr = w >> 2, wc = w & 3, l15 = lane & 15, quad = lane >> 4;
  char* const WS = opaque_ws(p.ws);
  const int BID = opaque_bid(); (void)BID;
  const u16* xb = (const u16*)(WS + OFF_XB);
  const u16* Wt = (const u16*)(WS + OFF_WT);
  const u16* Wbrt = (const u16*)(WS + OFF_WBR);
  const u16* grp = (const u16*)(WS + OFF_GRP);
  const float* rstd = (const float*)(WS + OFF_RSTD);
  u16* mixed = (u16*)(WS + OFF_MIXED);
  int bstart = BID;
  if (gridDim.x == 256) { const int x = BID & 7, j = BID >> 3; const int m = (x & 3) * 8 + (j & 7), n = (x >> 2) * 4 + (j >> 3);
    bstart = ((m >> 4) << 7) | (n << 4) | (m & 15); }
  for (int id = bstart; id < 256 * 8; id += gridDim.x) {
    const int mg = id >> 7, rem = id & 127, nt = rem >> 4, mt = mg * 16 + (rem & 15);
    const int m0 = mt * 128, n0 = nt * 256;
    unsigned mxp[4][4][2];
#pragma unroll
    for (int m = 0; m < 4; m++)
#pragma unroll
      for (int n = 0; n < 4; n++) { mxp[m][n][0] = 0u; mxp[m][n][1] = 0u; }
    for (int bb = 0; bb < 4; bb++) {
      unsigned gp[4][4][2];
      {
        f32x4 g[4][4];
#pragma unroll
        for (int m = 0; m < 4; m++)
#pragma unroll
          for (int n = 0; n < 4; n++) g[m][n] = zero4();
        gemm_core8<true>((const u16*)(WS + OFF_XB8) + (size_t)m0 * 1024, (const u16*)(WS + OFF_WM8) + (size_t)(bb * 2048 + n0) * 1024, g, smem);
#pragma unroll
        for (int m = 0; m < 4; m++) {
          const float rs1 = rstd[m0 + wr * 64 + m * 16 + l15] * (1.f / 64.f);
          const float rs_[4] = {rs1, rs1, rs1, rs1};
#pragma unroll
          for (int n = 0; n < 4; n++) {
            gp[m][n][0] = pack2(sigmoidf_(g[m][n][0] * rs_[0]), sigmoidf_(g[m][n][1] * rs_[1]));
            gp[m][n][1] = pack2(sigmoidf_(g[m][n][2] * rs_[2]), sigmoidf_(g[m][n][3] * rs_[3]));
          }
        }
      }
      f32x4 yv[4][4];
#pragma unroll
      for (int m = 0; m < 4; m++)
#pragma unroll
        for (int n = 0; n < 4; n++) yv[m][n] = zero4();
      gemm_core<4, true>(grp + (size_t)(3 + 4 * bb) * (SZ_GRP / 2) + (size_t)m0 * 512, 512, Wbrt + (size_t)(bb * 2048 + n0) * 512, 512, 512, yv, smem);
#pragma unroll
      for (int m = 0; m < 4; m++)
#pragma unroll
        for (int n = 0; n < 4; n++) {
          const float a0 = fmaf(__uint_as_float(gp[m][n][0] << 16), yv[m][n][0], __uint_as_float(mxp[m][n][0] << 16));
          const float a1 = fmaf(__uint_as_float(gp[m][n][0] & 0xffff0000u), yv[m][n][1], __uint_as_float(mxp[m][n][0] & 0xffff0000u));
          const float a2 = fmaf(__uint_as_float(gp[m][n][1] << 16), yv[m][n][2], __uint_as_float(mxp[m][n][1] << 16));
          const float a3 = fmaf(__uint_as_float(gp[m][n][1] & 0xffff0000u), yv[m][n][3], __uint_as_float(mxp[m][n][1] & 0xffff0000u));
          mxp[m][n][0] = pack2(a0, a1);
          mxp[m][n][1] = pack2(a2, a3);
        }
    }
#pragma unroll
    for (int m = 0; m < 4; m++)
#pragma unroll
      for (int n = 0; n < 4; n++)
        *(uint2*)(mixed + (size_t)(m0 + wr * 64 + m * 16 + l15) * D + n0 + wc * 64 + n * 16 + quad * 4) =
            make_uint2(mxp[m][n][0], mxp[m][n][1]);
  }
}

DI void phase4(const Params& p, int layer, char* smem) {
  const int tid = opaque_tid(), lane = tid & 63, w = tid >> 6, wr = w >> 2, wc = w & 3, l15 = lane & 15, quad = lane >> 4;
  char* const WS = opaque_ws(p.ws);
  const int BID = opaque_bid(); (void)BID;
  const u16* mixed = (const u16*)(WS + OFF_MIXED);
  const u16* Woutt = (const u16*)(WS + OFF_WOUT);
  const float* xs = layer == 0 ? p.x : p.out;
  for (int id = BID; id < 128 * 8; id += gridDim.x) {
    const int mg = id >> 7, rem = id & 127, nt = rem >> 4, mt = mg * 16 + (rem & 15);
    const int m0 = mt * 256, n0 = nt * 256;
    f32x4 acc[8][4];
#pragma unroll
    for (int m = 0; m < 8; m++)
#pragma unroll
      for (int n = 0; n < 4; n++) acc[m][n] = zero4();
    gemm_core<8, true>(mixed + (size_t)m0 * D, D, Woutt + (size_t)n0 * D, D, D, acc, smem);
#pragma unroll
    for (int m = 0; m < 8; m++)
#pragma unroll
      for (int n = 0; n < 4; n++)
      {
        const size_t idx = (size_t)(m0 + wr * 128 + m * 16 + l15) * D + n0 + wc * 64 + n * 16 + quad * 4;
        const float4 xv = *(const float4*)(xs + idx);
        *(float4*)(p.out + idx) = make_float4(xv.x + acc[m][n][0], xv.y + acc[m][n][1], xv.z + acc[m][n][2], xv.w + acc[m][n][3]);
      }
  }
}

DI void final_norm(const Params& p) {
  const int tid = opaque_tid(), lane = tid & 63, w = tid >> 6;
  char* const WS = opaque_ws(p.ws);
  const int BID = opaque_bid(); (void)BID;
  for (int row = BID * 8 + w; row < NT; row += gridDim.x * 8) {
    float4* s4 = (float4*)(p.out + (size_t)row * D);
    const float4* g4 = (const float4*)p.final_gain;
    float4 v[8];
    float ss = 0.f;
#pragma unroll
    for (int i = 0; i < 8; i++) { v[i] = s4[lane + 64 * i]; ss += v[i].x * v[i].x + v[i].y * v[i].y + v[i].z * v[i].z + v[i].w * v[i].w; }
    ss = wave_sum(ss);
    const float r = rsqrtf(ss * (1.f / D) + 1e-6f);
#pragma unroll
    for (int i = 0; i < 8; i++) {
      float4 g = g4[lane + 64 * i];
      s4[lane + 64 * i] = make_float4(v[i].x * r * g.x, v[i].y * r * g.y, v[i].z * r * g.z, v[i].w * r * g.w);
    }
  }
}

#ifndef PH
#define PH 1023
#endif
#ifndef PROBE_MASK
#define PROBE_MASK 0
#endif
#ifndef PROBE_BLOCK
#define PROBE_BLOCK 0
#endif
#ifndef EN_A
#define EN_A 1
#endif
#ifndef EN_B
#define EN_B 1
#endif
#ifndef EN_C
#define EN_C 1
#endif
#ifndef EN_D
#define EN_D 1
#endif

__global__ void __launch_bounds__(NTHREADS) mega(Params p) {
  extern __shared__ __attribute__((aligned(16))) char smem[];
  cg::grid_group grid = cg::this_grid();
  int* cnt = (int*)(p.ws + OFF_CNT);
  long long tacc = 0, tq = 0;
#define TB(bit) if (PROBE_MASK & (bit)) tq = wall_clock64();
#define TE(bit) if (PROBE_MASK & (bit)) tacc += wall_clock64() - tq;
  for (int layer = 0; layer < 2; layer++) {
    TB(1)
#if PH&1
    phase0(p, layer, smem);
#endif
    grid.sync();
    TE(1)
    TB(2)
#if PH&2
    phase1(p, smem);
#endif
    grid.sync();
    TE(2)
    TB(4)
    for (;;) {
      int it = next_item(cnt + layer * 2);
      if (it >= 2048 + 2048 + 1024) break;
#if PH&4
      TB(128)
      if (it < 2048) c_prepass(p, layer, it, smem);
      TE(128)
#endif
#if PH&8
      TB(256)
      if (it >= 2048 && it < 4096) d_prepass(p, layer, it - 2048, smem);
      TE(256)
#endif
#if PH&16
      if (it >= 4096) attn_item<64, 1, true>(p, layer, it - 4096, smem);
#endif
    }
    grid.sync();
    TE(4)
    TB(8)
#if PH&32
    TB(64)
    const int sbid = opaque_bid();
    if (sbid < 16) scan_item<true>(p, layer, sbid, smem);
    TE(64)
#endif
#if PH&64
    TB(512)
    if (sbid >= 16 && sbid < 32) scan_item<false>(p, layer, sbid - 16, smem);
    TE(512)
#endif
    for (;;) {
      int it = next_item(cnt + layer * 2 + 1);
      if (it >= 1024) break;
#if PH&128
      attn_item<128, 2, false>(p, layer, it, smem);
#endif
    }
    grid.sync();
    TE(8)
    TB(16)
    scan_post(p, layer);
    grid.sync();
#if PH&256
    phase3(p, smem);
#endif
    grid.sync();
    TE(16)
    TB(32)
#if PH&512
    phase4(p, layer, smem);
#endif
    grid.sync();
    TE(32)
  }
  final_norm(p);
  if (PROBE_MASK && blockIdx.x == PROBE_BLOCK) { long long tend = wall_clock64() + tacc; while (wall_clock64() < tend) __builtin_amdgcn_s_sleep(20); }
}

extern "C" void kernel_launch(void* const* d_in, const int* in_sizes, int n_in, void* d_out, int out_size, void* d_ws,
                              size_t ws_size, hipStream_t stream) {
  static int grid_blocks = 0;
  if (!grid_blocks) {
    int dev = 0, cus = 0, per_cu = 0;
    hipGetDevice(&dev);
    hipDeviceGetAttribute(&cus, hipDeviceAttributeMultiprocessorCount, dev);
    hipFuncSetAttribute((const void*)mega, hipFuncAttributeMaxDynamicSharedMemorySize, LDS_BYTES);
    hipOccupancyMaxActiveBlocksPerMultiprocessor(&per_cu, (const void*)mega, NTHREADS, LDS_BYTES);
    if (per_cu < 1) per_cu = 1;
    grid_blocks = cus * per_cu;
    if (ws_size < OFF_END) fprintf(stderr, "kernel_launch: workspace too small: %zu < %zu\n", ws_size, (size_t)OFF_END);
  }
  Params p{};
  p.x = (const float*)d_in[0]; p.norm_gain = (const float*)d_in[1]; p.w_in = (const float*)d_in[2];
  p.rel_bias = (const float*)d_in[3]; p.diff_lambda = (const float*)d_in[4]; p.diff_subln = (const float*)d_in[5];
  p.dn_conv = (const float*)d_in[6]; p.dn_a_log = (const float*)d_in[7]; p.dn_dt_bias = (const float*)d_in[8];
  p.dn_norm_gain = (const float*)d_in[9]; p.hg_lb_logits = (const float*)d_in[10]; p.hg_norm_gain = (const float*)d_in[11];
  p.w_branch = (const float*)d_in[12]; p.w_out = (const float*)d_in[13]; p.final_gain = (const float*)d_in[14];
  p.out = (float*)d_out; p.ws = (char*)d_ws;
  void* args[] = {&p};
  hipError_t e = hipLaunchCooperativeKernel((void*)mega, dim3(grid_blocks), dim3(NTHREADS), args, LDS_BYTES, stream);
  if (e != hipSuccess) fprintf(stderr, "cooperative launch failed: %s (grid %d)\n", hipGetErrorString(e), grid_blocks);
}
```
